# Optimizing an MI355X kernel written in HIP

```python
import jax, jax.numpy as jnp
from jax import lax
import numpy as np

D_MODEL = 1024
BATCH = 4
SEQ = 4096
DEPTH = 1

MIX_WIDTH = D_MODEL
SB_WIDTH = MIX_WIDTH // 2
SB_HEAD_DIM = 64
SB_HEADS = SB_WIDTH // SB_HEAD_DIM
HG_WIDTH = MIX_WIDTH - SB_WIDTH
HG_HEAD_DIM = 128
HG_HEADS = HG_WIDTH // HG_HEAD_DIM
D_FF = 2816
Q_BLOCK = 128
HG_CHUNK = 64
EPS = 1e-6
IN_WIDTHS = (SB_WIDTH, SB_WIDTH, SB_WIDTH, HG_WIDTH, HG_WIDTH, HG_WIDTH, HG_WIDTH)
IN_COLS = sum(IN_WIDTHS)
IN_SPLITS = tuple(int(s) for s in np.cumsum(IN_WIDTHS)[:-1])

kernel_name = "hybrid_stickbreak_hgrn2_macaron"


def rmsnorm(x, gain):
    xf = x.astype(jnp.float32)
    y = xf * lax.rsqrt(jnp.mean(xf * xf, axis=-1, keepdims=True) + EPS)
    return (y * gain.astype(jnp.float32)).astype(x.dtype)


def head_rmsnorm(o, gain, n_heads, head_dim):
    B, T, _ = o.shape
    of = o.astype(jnp.float32).reshape(B, T, n_heads, head_dim)
    of = of * lax.rsqrt(jnp.mean(of * of, axis=-1, keepdims=True) + EPS)
    return of.reshape(B, T, n_heads * head_dim) * gain.astype(jnp.float32)


def swiglu(h, w_gate, w_up, w_down):
    return (jax.nn.silu(h @ w_gate) * (h @ w_up)) @ w_down


def split_heads(a, n_heads, head_dim):
    B, T, _ = a.shape
    return a.reshape(B, T, n_heads, head_dim).transpose(0, 2, 1, 3)


def merge_heads(a):
    B, H, T, Dh = a.shape
    return a.transpose(0, 2, 1, 3).reshape(B, T, H * Dh)


def stick_breaking_attention(q, k, v):
    B, H, T, Dh = q.shape
    n_blocks = T // Q_BLOCK
    scale = Dh ** -0.5
    q_blocks = q.reshape(B, H, n_blocks, Q_BLOCK, Dh).transpose(2, 0, 1, 3, 4)
    key_pos = jnp.arange(T)

    def block(args):
        q_blk, blk_idx = args
        z = jnp.einsum('bhqd,bhkd->bhqk', q_blk, k) * scale
        q_pos = blk_idx * Q_BLOCK + jnp.arange(Q_BLOCK)
        causal = key_pos[None, :] < q_pos[:, None]
        log_beta = jax.nn.log_sigmoid(z)
        log_rest = jnp.where(causal, jax.nn.log_sigmoid(-z), 0.0)
        tail = lax.cumsum(log_rest, axis=3, reverse=True) - log_rest
        w = jnp.where(causal, jnp.exp(log_beta + tail), 0.0)
        return jnp.einsum('bhqk,bhkd->bhqd', w, v)

    out = lax.map(block, (q_blocks, jnp.arange(n_blocks)))
    return out.transpose(1, 2, 0, 3, 4).reshape(B, H, T, Dh)


def hgrn2_chunkwise(q, k, v, log_f):
    B, H, T, Dk = q.shape
    Dv = v.shape[-1]
    n = T // HG_CHUNK

    def to_chunks(a):
        return a.reshape(B, H, n, HG_CHUNK, a.shape[-1]).transpose(2, 0, 1, 3, 4)

    qc, kc, vc = to_chunks(q), to_chunks(k), to_chunks(v)
    bc = lax.cumsum(to_chunks(log_f), axis=3)
    idx = jnp.arange(HG_CHUNK)
    incl = (idx[:, None] >= idx[None, :])[:, :, None]

    def step(S, xs):
        q_c, k_c, v_c, b_c = xs
        diff = b_c[:, :, :, None, :] - b_c[:, :, None, :, :]
        decay = jnp.where(incl, jnp.exp(jnp.minimum(diff, 0.0)), 0.0)
        scores = jnp.einsum('bhtd,bhsd,bhtsd->bhts', q_c, k_c, decay)
        o_intra = jnp.einsum('bhts,bhsv->bhtv', scores, v_c)
        o_inter = jnp.einsum('bhtd,bhdv->bhtv', q_c * jnp.exp(b_c), S)
        b_last = b_c[:, :, -1:, :]
        S_new = jnp.exp(b_last[:, :, 0, :])[..., None] * S + jnp.einsum(
            'bhsd,bhsv->bhdv', k_c * jnp.exp(b_last - b_c), v_c)
        return S_new, o_intra + o_inter

    S0 = jnp.zeros((B, H, Dk, Dv), jnp.float32)
    _, o = lax.scan(step, S0, (qc, kc, vc, bc))
    return o.transpose(1, 2, 0, 3, 4).reshape(B, H, T, Dv)


def setup_inputs(seed: int = 0) -> dict:
    key = jax.random.key(seed)
    ks = jax.random.split(key, 20)
    f32 = jnp.float32

    def normal(k, shape, scale):
        return jax.random.normal(k, shape, f32) * scale

    def gain(k, shape):
        return 1.0 + 0.02 * jax.random.normal(k, shape, f32)

    return {
        "x": jax.random.normal(ks[0], (BATCH, SEQ, D_MODEL), f32),
        "ffn1_norm": gain(ks[1], (DEPTH, D_MODEL)),
        "ffn1_w_gate": normal(ks[2], (DEPTH, D_MODEL, D_FF), D_MODEL ** -0.5),
        "ffn1_w_up": normal(ks[3], (DEPTH, D_MODEL, D_FF), D_MODEL ** -0.5),
        "ffn1_w_down": normal(ks[4], (DEPTH, D_FF, D_MODEL), D_FF ** -0.5),
        "mix_norm": gain(ks[5], (DEPTH, D_MODEL)),
        "w_in": normal(ks[6], (DEPTH, D_MODEL, IN_COLS), D_MODEL ** -0.5),
        "sb_out_norm": gain(ks[7], (DEPTH, SB_WIDTH)),
        "hg_lower_bound_logits": normal(ks[8], (DEPTH + 1, HG_WIDTH), 0.1),
        "hg_out_norm": gain(ks[9], (DEPTH, HG_WIDTH)),
        "w_out": normal(ks[10], (DEPTH, MIX_WIDTH, D_MODEL), MIX_WIDTH ** -0.5),
        "ffn2_norm": gain(ks[11], (DEPTH, D_MODEL)),
        "ffn2_w_gate": normal(ks[12], (DEPTH, D_MODEL, D_FF), D_MODEL ** -0.5),
        "ffn2_w_up": normal(ks[13], (DEPTH, D_MODEL, D_FF), D_MODEL ** -0.5),
        "ffn2_w_down": normal(ks[14], (DEPTH, D_FF, D_MODEL), D_FF ** -0.5),
        "final_norm": gain(ks[15], (D_MODEL,)),
    }


def reference(x, ffn1_norm, ffn1_w_gate, ffn1_w_up, ffn1_w_down, mix_norm, w_in, sb_out_norm,
              hg_lower_bound_logits, hg_out_norm, w_out, ffn2_norm, ffn2_w_gate, ffn2_w_up,
              ffn2_w_down, final_norm):
    f32 = jnp.float32
    lower_bounds = lax.cumsum(jax.nn.softmax(hg_lower_bound_logits.astype(f32), axis=0), axis=0)

    for l in range(DEPTH):
        h = rmsnorm(x, ffn1_norm[l])
        x = x + 0.5 * swiglu(h, ffn1_w_gate[l], ffn1_w_up[l], ffn1_w_down[l])

        h = rmsnorm(x, mix_norm[l])
        proj = h @ w_in[l]
        q_sb, k_sb, v_sb, q_hg, f_hg, i_hg, g_hg = jnp.split(proj, IN_SPLITS, axis=-1)

        o_sb = stick_breaking_attention(split_heads(q_sb.astype(f32), SB_HEADS, SB_HEAD_DIM),
                                        split_heads(k_sb.astype(f32), SB_HEADS, SB_HEAD_DIM),
                                        split_heads(v_sb.astype(f32), SB_HEADS, SB_HEAD_DIM))
        o_sb = head_rmsnorm(merge_heads(o_sb), sb_out_norm[l], SB_HEADS, SB_HEAD_DIM)

        lb = lower_bounds[l]
        forget = lb + (1.0 - lb) * jax.nn.sigmoid(f_hg.astype(f32))
        q_h = jax.nn.silu(q_hg.astype(f32))
        o_hg = hgrn2_chunkwise(split_heads(q_h, HG_HEADS, HG_HEAD_DIM),
                               split_heads(1.0 - forget, HG_HEADS, HG_HEAD_DIM),
                               split_heads(i_hg.astype(f32), HG_HEADS, HG_HEAD_DIM),
                               split_heads(jnp.log(forget), HG_HEADS, HG_HEAD_DIM))
        o_hg = head_rmsnorm(merge_heads(o_hg), hg_out_norm[l], HG_HEADS, HG_HEAD_DIM) * jax.nn.silu(g_hg.astype(f32))

        mixed = jnp.concatenate([o_sb, o_hg], axis=-1).astype(x.dtype)
        x = x + mixed @ w_out[l]

        h = rmsnorm(x, ffn2_norm[l])
        x = x + 0.5 * swiglu(h, ffn2_w_gate[l], ffn2_w_up[l], ffn2_w_down[l])

    return rmsnorm(x, final_norm)
```

```cpp
#include <hip/hip_runtime.h>
#include <hip/hip_cooperative_groups.h>
#include <cstdio>
#include <cstdint>
namespace cg = cooperative_groups;
namespace pg8 {
#define PG8_LAS __attribute__((address_space(3)))
typedef unsigned short bf16_t;
typedef short bf16x8 __attribute__((ext_vector_type(8)));
typedef float f32x4 __attribute__((ext_vector_type(4)));
typedef unsigned u32x4 __attribute__((ext_vector_type(4)));
constexpr int BM = 256, BK = 64, HALF = 128, HTB = HALF * BK * 2  , STAGE_BYTES = 8 * HTB, NXCD = 8, WGM = 8;

__host__ __device__ __forceinline__ int lds_byte(int r, int c) { const int st = (r >> 4) * 2 + (c >> 5), rr = r & 15, cc = c & 31, ob = rr * 64 + cc * 2; return st * 1024 + (ob ^ (((ob >> 9) & 1) << 5)); }
__host__ __device__ __forceinline__ void stage_rc(int b, int& R, int& C) { const int st = b / 1024, sb = b % 1024, swz = sb ^ (((sb >> 9) & 1) << 5); R = (st >> 1) * 16 + swz / 64; C = (st & 1) * 32 + (swz % 64) / 2; }
__host__ __device__ __forceinline__ int perm32(int rho) { const int n = rho >> 4, i = rho & 15; return 8 * (i >> 2) + 4 * n + (i & 3); }

struct Unit { int pm, pn; };
struct Gemm { const bf16_t* A; const bf16_t* Bt; int M, N, K; };

struct StaticOrder {
    int nM, nN, nwg, G, c;
    __host__ __device__ void init(int M, int N, int G_, int c_) { nM = M / BM; nN = N / BM; nwg = nM * nN; G = G_; c = c_; }
    __host__ __device__ bool next(int i, Unit& u) const {
        const long L = (long)i * G + c; if (L >= nwg) return false;
        int wgid = (int)L; { const int q = nwg / NXCD, r = nwg % NXCD, xcd = wgid % NXCD, off = wgid / NXCD; wgid = (xcd < r ? xcd * (q + 1) : r * (q + 1) + (xcd - r) * q) + off; }
        const int nig = WGM * nN, gid = wgid / nig, fm = gid * WGM, gsz = (nM - fm) < WGM ? (nM - fm) : WGM;
        u.pm = fm + ((wgid % nig) % gsz); u.pn = (wgid % nig) / gsz; return true;
    }
    __device__ __forceinline__ void a_ready(const Unit&) const {}
    __device__ __forceinline__ void done(const Unit&) const {}
};
__device__ __forceinline__ unsigned cvt_pk_bf16(float lo, float hi) { unsigned r; asm volatile("v_cvt_pk_bf16_f32 %0, %1, %2" : "=v"(r) : "v"(lo), "v"(hi)); return r; }
typedef float f32x2 __attribute__((ext_vector_type(2)));
template <class Epi, class Sched, bool ALIGN_EPI = false, bool SP2 = false>
__device__ __forceinline__ void gemm_phase(PG8_LAS unsigned char* lds, const Gemm g, const Sched& S, const Epi& E) {
    const int tid = threadIdx.x, wid = __builtin_amdgcn_readfirstlane(tid >> 6), lane = tid & 63, wr = wid >> 2, wc = wid & 3, fr = lane & 15, fq = lane >> 4;
    const int K = g.K, nt = K / BK;
    unsigned voffA[2], voffB[2];
#pragma unroll
    for (int i = 0; i < 2; ++i) { int R, C; stage_rc(tid * 16 + i * 8192, R, C); const int Rb = Epi::PERM ? ((R & ~31) + perm32(R & 31)) : R;
        voffA[i] = (unsigned)(R * K + C) * 2u; voffB[i] = (unsigned)(Rb * K + C) * 2u; }
    const size_t kstep = (size_t)(BK * 2);
    const size_t hstep = (size_t)HALF * K * 2;
    const size_t tstep = 2 * hstep;
    const unsigned ldsw = (unsigned)wid * 1024u;
    const int aoff = lds_byte(wr * 64 + fr, fq * 8), boff = lds_byte(wc * 32 + fr, fq * 8);
#define PG8_SA(b, h) (((b) * 2 + (h)) * HTB)
#define PG8_SB(b, h) ((4 + (b) * 2 + (h)) * HTB)
#define PG8_STAGE(bufoff, gbase, voff) do { _Pragma("unroll") for (int _i = 0; _i < 2; ++_i) \
        __builtin_amdgcn_global_load_lds((const unsigned*)((const char*)(gbase) + (voff)[_i]), (PG8_LAS unsigned*)(lds + (bufoff) + ldsw + _i * 8192), 16, 0, 0); } while (0)
#define PG8_LDA(dst, b, h) do { _Pragma("unroll") for (int m = 0; m < 4; ++m) _Pragma("unroll") for (int k = 0; k < 2; ++k) dst[m][k] = *(const PG8_LAS bf16x8*)(lds + PG8_SA(b, h) + aoff + m * 2048 + k * 1024); } while (0)
#define PG8_LDB(dst, b, h) do { _Pragma("unroll") for (int n = 0; n < 2; ++n) _Pragma("unroll") for (int k = 0; k < 2; ++k) dst[n][k] = *(const PG8_LAS bf16x8*)(lds + PG8_SB(b, h) + boff + n * 2048 + k * 1024); } while (0)
#define PG8_MMA(ai, bj, At, Bt) do { __builtin_amdgcn_s_setprio(1); _Pragma("unroll") for (int m = 0; m < 4; ++m) _Pragma("unroll") for (int n = 0; n < 2; ++n) _Pragma("unroll") for (int k = 0; k < 2; ++k) \
        acc[ai][bj][m][n] = __builtin_amdgcn_mfma_f32_16x16x32_bf16(Bt[n][k], At[m][k], acc[ai][bj][m][n], 0, 0, 0); __builtin_amdgcn_s_setprio(0); } while (0)
#define PG8_WAIT_V(n) asm volatile("s_waitcnt vmcnt(" #n ")" ::: "memory")
#define PG8_WAIT_L(n) asm volatile("s_waitcnt lgkmcnt(" #n ")" ::: "memory")
#define PG8_BAR __builtin_amdgcn_s_barrier()
#define PG8_SCHED __builtin_amdgcn_sched_barrier(0)
    Unit cur, nxt; int ui = 0;
    if (!S.next(0, cur)) return;
    f32x4 acc[2][2][4][2];
#pragma unroll
    for (int a = 0; a < 2; ++a)
#pragma unroll
        for (int b = 0; b < 2; ++b)
#pragma unroll
            for (int m = 0; m < 4; ++m)
#pragma unroll
                for (int n = 0; n < 2; ++n) acc[a][b][m][n] = (f32x4){0.f, 0.f, 0.f, 0.f};
    bf16x8 At[4][2], B0[2][2], B1[2][2];
    const char* cA = (const char*)g.A + (size_t)cur.pm * tstep; const char* cB = (const char*)g.Bt + (size_t)cur.pn * tstep;
    S.a_ready(cur);
    if constexpr (SP2) {
        PG8_STAGE(PG8_SB(0, 0), cB, voffB); PG8_STAGE(PG8_SB(0, 1), cB + hstep, voffB); PG8_STAGE(PG8_SA(0, 0), cA, voffA); PG8_STAGE(PG8_SA(0, 1), cA + hstep, voffA);
        if (wr == 1) PG8_BAR;
        PG8_WAIT_V(2); PG8_BAR;
        PG8_STAGE(PG8_SB(1, 0), cB + kstep, voffB); PG8_STAGE(PG8_SA(1, 0), cA + kstep, voffA); PG8_STAGE(PG8_SB(1, 1), cB + hstep + kstep, voffB);
        PG8_WAIT_V(6); PG8_BAR;
    } else {
        PG8_STAGE(PG8_SB(0, 0), cB, voffB); PG8_STAGE(PG8_SA(0, 0), cA, voffA); PG8_STAGE(PG8_SB(0, 1), cB + hstep, voffB); PG8_STAGE(PG8_SA(0, 1), cA + hstep, voffA);
        if (wr == 1) PG8_BAR;
        PG8_WAIT_V(4); PG8_BAR;
        PG8_STAGE(PG8_SB(1, 0), cB + kstep, voffB); PG8_STAGE(PG8_SA(1, 0), cA + kstep, voffA); PG8_STAGE(PG8_SB(1, 1), cB + hstep + kstep, voffB);
        PG8_WAIT_V(6); PG8_BAR;
    }
    for (;;) {
        const bool has_next = S.next(ui + 1, nxt);
        const char* nA = has_next ? (const char*)g.A + (size_t)nxt.pm * tstep : cA; const char* nB = has_next ? (const char*)g.Bt + (size_t)nxt.pn * tstep : cB;
        for (int t = 0; t < nt; t += 2) {
            const bool last = (t == nt - 2);
            const char* a1 = cA + (size_t)(t + 1) * kstep;
            const char* a2 = last ? nA : cA + (size_t)(t + 2) * kstep; const char* b2 = last ? nB : cB + (size_t)(t + 2) * kstep;
            const char* a3 = a2 + kstep; const char* b3 = b2 + kstep;
            if (last && has_next) S.a_ready(nxt);
            if constexpr (SP2) {
            PG8_LDB(B0, 0, 0); PG8_LDB(B1, 0, 1); PG8_SCHED; PG8_LDA(At, 0, 0); PG8_STAGE(PG8_SA(1, 1), a1 + hstep, voffA);
            PG8_WAIT_V(8); PG8_WAIT_L(0); PG8_BAR; PG8_MMA(0, 0, At, B0); PG8_MMA(0, 1, At, B1); PG8_BAR; PG8_SCHED;
            PG8_LDA(At, 0, 1); PG8_STAGE(PG8_SB(0, 0), b2, voffB); PG8_STAGE(PG8_SB(0, 1), b2 + hstep, voffB); PG8_STAGE(PG8_SA(0, 0), a2, voffA);
            PG8_WAIT_V(8); PG8_WAIT_L(0); PG8_BAR; PG8_MMA(1, 0, At, B0); PG8_MMA(1, 1, At, B1); PG8_BAR; PG8_SCHED;
            PG8_LDB(B0, 1, 0); PG8_LDB(B1, 1, 1); PG8_SCHED; PG8_LDA(At, 1, 0); PG8_STAGE(PG8_SA(0, 1), a2 + hstep, voffA);
            PG8_WAIT_V(8); PG8_WAIT_L(0); PG8_BAR; PG8_MMA(0, 0, At, B0); PG8_MMA(0, 1, At, B1); PG8_BAR; PG8_SCHED;
            PG8_LDA(At, 1, 1); PG8_STAGE(PG8_SB(1, 0), b3, voffB); PG8_STAGE(PG8_SB(1, 1), b3 + hstep, voffB); PG8_STAGE(PG8_SA(1, 0), a3, voffA);
            PG8_WAIT_V(8); PG8_WAIT_L(0); PG8_BAR; PG8_MMA(1, 0, At, B0); PG8_MMA(1, 1, At, B1); PG8_BAR; PG8_SCHED;
            } else {
            PG8_LDB(B0, 0, 0); PG8_SCHED; PG8_LDA(At, 0, 0); PG8_STAGE(PG8_SA(1, 1), a1 + hstep, voffA);
            PG8_WAIT_L(8); PG8_BAR; PG8_WAIT_L(0); PG8_MMA(0, 0, At, B0); PG8_BAR; PG8_SCHED;
            PG8_LDB(B1, 0, 1); PG8_STAGE(PG8_SB(0, 0), b2, voffB);
            PG8_BAR; PG8_WAIT_L(0); PG8_MMA(0, 1, At, B1); PG8_BAR;
            PG8_LDA(At, 0, 1); PG8_STAGE(PG8_SA(0, 0), a2, voffA);
            PG8_BAR; PG8_WAIT_L(0); PG8_MMA(1, 0, At, B0); PG8_BAR; PG8_SCHED;
            PG8_STAGE(PG8_SB(0, 1), b2 + hstep, voffB);
            PG8_WAIT_V(6); PG8_BAR; PG8_MMA(1, 1, At, B1); PG8_BAR;
            PG8_LDB(B0, 1, 0); PG8_SCHED; PG8_LDA(At, 1, 0); PG8_STAGE(PG8_SA(0, 1), a2 + hstep, voffA);
            PG8_WAIT_L(8); PG8_BAR; PG8_WAIT_L(0); PG8_MMA(0, 0, At, B0); PG8_BAR; PG8_SCHED;
            PG8_LDB(B1, 1, 1); PG8_STAGE(PG8_SB(1, 0), b3, voffB);
            PG8_BAR; PG8_WAIT_L(0); PG8_MMA(0, 1, At, B1); PG8_BAR;
            PG8_LDA(At, 1, 1); PG8_STAGE(PG8_SA(1, 0), a3, voffA);
            PG8_BAR; PG8_WAIT_L(0); PG8_MMA(1, 0, At, B0); PG8_BAR; PG8_SCHED;
            PG8_STAGE(PG8_SB(1, 1), b3 + hstep, voffB);
            PG8_WAIT_V(6); PG8_BAR; PG8_MMA(1, 1, At, B1); PG8_BAR;
            }
        }
        if constexpr (ALIGN_EPI) { if (wr == 0) PG8_BAR; }
        if constexpr (!Epi::AFTER_DRAIN) { E(acc, cur, wr, wc, fr, fq); S.done(cur); }
        if (!has_next) break;
#pragma unroll
        for (int a = 0; a < 2; ++a)
#pragma unroll
            for (int b = 0; b < 2; ++b)
#pragma unroll
                for (int m = 0; m < 4; ++m)
#pragma unroll
                    for (int n = 0; n < 2; ++n) acc[a][b][m][n] = (f32x4){0.f, 0.f, 0.f, 0.f};
        cur = nxt; cA = nA; cB = nB; ++ui;
        if constexpr (ALIGN_EPI) { if (wr == 1) PG8_BAR; }
    }
    PG8_WAIT_V(0);
    if constexpr (!ALIGN_EPI) { if (wr == 0) PG8_BAR; }
    PG8_BAR;
    if constexpr (Epi::AFTER_DRAIN) { E.fused(acc, cur, wr, wc, fr, fq, lds, wid, lane); S.done(cur); }
#undef PG8_SA
#undef PG8_SB
#undef PG8_STAGE
#undef PG8_LDA
#undef PG8_LDB
#undef PG8_MMA
#undef PG8_WAIT_V
#undef PG8_WAIT_L
#undef PG8_BAR
#undef PG8_SCHED
}
}
using pg8::bf16_t; using pg8::bf16x8; using pg8::f32x4; using pg8::u32x4; using pg8::Unit;
typedef float f32x2_t __attribute__((ext_vector_type(2))); typedef __bf16 bf16x2_t __attribute__((ext_vector_type(2)));
__device__ __forceinline__ unsigned cvt_pk_bf16(float lo, float hi) { f32x2_t v = {lo, hi}; bf16x2_t b = __builtin_convertvector(v, bf16x2_t); return __builtin_bit_cast(unsigned, b); }
typedef unsigned u32x2 __attribute__((ext_vector_type(2)));
#define LAS __attribute__((address_space(3)))

constexpr int NTOK = 16384, DM = 1024, DFF = 2816, SEQ = 4096, NIN = 3584, NTHR = 512;
constexpr float EPS = 1e-6f;
constexpr size_t MiB = 1u << 20;
constexpr size_t WS_CTL = 0, WS_LBV = 64 * 1024, WS_DECAY = 1 * MiB, WS_PART0 = 2 * MiB, WS_PART1 = 3 * MiB, WS_PART2 = 4 * MiB;
constexpr size_t WS_W1GU = 6 * MiB, WS_W1D = 17 * MiB, WS_WIN = 22 * MiB + MiB / 2, WS_WOUT = 29 * MiB + MiB / 2, WS_W2GU = 31 * MiB + MiB / 2, WS_W2D = 42 * MiB + MiB / 2;
constexpr size_t WS_XB = 48 * MiB;
constexpr size_t WS_ACT = 80 * MiB;
constexpr size_t WS_QSB = 80 * MiB, WS_KSB = 96 * MiB, WS_VTSB = 112 * MiB, WS_QHG = 128 * MiB, WS_VTHG = 144 * MiB, WS_GHG = 160 * MiB;
constexpr size_t WS_LOGF = 176 * MiB;
constexpr size_t WS_LT = 208 * MiB;
constexpr size_t WS_XB2 = 176 * MiB;
constexpr size_t WS_END = 240 * MiB;

__device__ __forceinline__ float bf2f(unsigned short u) { return __uint_as_float((unsigned)u << 16); }
__device__ __forceinline__ bf16_t f2bf(float x) { return (bf16_t)(cvt_pk_bf16(x, 0.f) & 0xffffu); }
__device__ __forceinline__ float silu_f(float v) { return v * __builtin_amdgcn_rcpf(1.0f + __expf(-v)); }
__device__ __forceinline__ u32x4 pack8(const float* r) { u32x4 w; w.x = cvt_pk_bf16(r[0], r[1]); w.y = cvt_pk_bf16(r[2], r[3]); w.z = cvt_pk_bf16(r[4], r[5]); w.w = cvt_pk_bf16(r[6], r[7]); return w; }
__device__ __forceinline__ float row_rs(const float* part, int row, int fq) {
    const f32x4 p = *(const f32x4*)(part + (size_t)row * 16 + 4 * fq);
    float s = (p.x + p.y) + (p.z + p.w);
    s += __shfl_xor(s, 16); s += __shfl_xor(s, 32);
    return __builtin_amdgcn_rsqf(s * (1.0f / 1024.0f) + EPS);
}

struct EpiSwiglu {
    static constexpr bool PERM = true, AFTER_DRAIN = false;
    bf16_t* O; const float* part;
    __device__ __forceinline__ void operator()(const f32x4 (&acc)[2][2][4][2], const Unit& u, int wr, int wc, int fr, int fq) const {
        const int row0 = u.pm * 256 + wr * 64 + fr, col0 = u.pn * 128 + wc * 32 + 8 * fq;
#pragma unroll
        for (int ai = 0; ai < 2; ++ai)
#pragma unroll
            for (int m = 0; m < 4; ++m) {
                const int row = row0 + ai * 128 + m * 16;
                const float rs = row_rs(part, row, fq);
                float r[8];
#pragma unroll
                for (int n = 0; n < 2; ++n)
#pragma unroll
                    for (int j = 0; j < 4; ++j) { const float g = acc[ai][0][m][n][j] * rs, uu = acc[ai][1][m][n][j] * rs; r[n * 4 + j] = silu_f(g) * uu; }
                *(u32x4*)(O + (size_t)row * DFF + col0) = pack8(r);
            }
    }
};
struct EpiResid {
    static constexpr bool PERM = true, AFTER_DRAIN = false;
    const float* base; float* out; bf16_t* ob; float* part; float alpha;
    __device__ __forceinline__ void operator()(const f32x4 (&acc)[2][2][4][2], const Unit& u, int wr, int wc, int fr, int fq) const {
        const int row0 = u.pm * 256 + wr * 64 + fr, col0 = u.pn * 256 + wc * 32 + 8 * fq;
#pragma unroll
        for (int ai = 0; ai < 2; ++ai)
#pragma unroll
            for (int m = 0; m < 4; ++m) {
                const int row = row0 + ai * 128 + m * 16; float ss = 0.f;
#pragma unroll
                for (int bj = 0; bj < 2; ++bj) {
                    const size_t off = (size_t)row * DM + col0 + bj * 128;
                    const f32x4 b0 = *(const f32x4*)(base + off), b1 = *(const f32x4*)(base + off + 4);
                    const f32x4 v0 = b0 + acc[ai][bj][m][0] * alpha, v1 = b1 + acc[ai][bj][m][1] * alpha;
                    *(f32x4*)(out + off) = v0; *(f32x4*)(out + off + 4) = v1;
                    ss += (v0.x * v0.x + v0.y * v0.y) + (v0.z * v0.z + v0.w * v0.w) + (v1.x * v1.x + v1.y * v1.y) + (v1.z * v1.z + v1.w * v1.w);
                    if (ob) { const float r[8] = {v0.x, v0.y, v0.z, v0.w, v1.x, v1.y, v1.z, v1.w}; *(u32x4*)(ob + off) = pack8(r); }
                }
                if (part) { ss += __shfl_xor(ss, 16); ss += __shfl_xor(ss, 32); if (fq == 0) part[(size_t)row * 16 + u.pn * 4 + wc] = ss; }
            }
    }
};
struct EpiMix {
    static constexpr bool PERM = true, AFTER_DRAIN = false;
    const float* part; bf16_t *Qsb, *Ksb, *VTsb, *Qhg, *VThg, *Ghg; float* LogF; const float* lbv;
    __device__ __forceinline__ void operator()(const f32x4 (&acc)[2][2][4][2], const Unit& u, int wr, int wc, int fr, int fq) const {
        const int typ = u.pn >> 1;
        const int row0 = u.pm * 256 + wr * 64 + fr, cg0 = (u.pn & 1) * 256 + wc * 32 + 8 * fq;
#pragma unroll
        for (int ai = 0; ai < 2; ++ai)
#pragma unroll
            for (int m = 0; m < 4; ++m) {
                const int row = row0 + ai * 128 + m * 16;
                const float rs = row_rs(part, row, fq);
#pragma unroll
                for (int bj = 0; bj < 2; ++bj) {
                    const int cg = cg0 + bj * 128;
                    float r[8];
#pragma unroll
                    for (int n = 0; n < 2; ++n)
#pragma unroll
                        for (int j = 0; j < 4; ++j) r[n * 4 + j] = acc[ai][bj][m][n][j] * rs;
                    const size_t off = (size_t)row * 512 + cg;
                    if (typ == 0) {
#pragma unroll
                        for (int j = 0; j < 8; ++j) r[j] *= 0.125f;
                        *(u32x4*)(Qsb + off) = pack8(r);
                    } else if (typ == 1) {
                        *(u32x4*)(Ksb + off) = pack8(r);
                    } else if (typ == 2 || typ == 5) {
                        bf16_t* dst = (typ == 2 ? VTsb : VThg) + ((size_t)(row >> 12) * 512 + cg) * SEQ + (row & (SEQ - 1));
#pragma unroll
                        for (int j = 0; j < 8; ++j) dst[(size_t)j * SEQ] = f2bf(r[j]);
                    } else if (typ == 3 || typ == 6) {
#pragma unroll
                        for (int j = 0; j < 8; ++j) r[j] = silu_f(r[j]);
                        *(u32x4*)((typ == 3 ? Qhg : Ghg) + off) = pack8(r);
                    } else {
                        const f32x4 l0 = *(const f32x4*)(lbv + cg), l1 = *(const f32x4*)(lbv + cg + 4);
                        const float lb[8] = {l0.x, l0.y, l0.z, l0.w, l1.x, l1.y, l1.z, l1.w};
#pragma unroll
                        for (int j = 0; j < 8; ++j) { const float sg = __builtin_amdgcn_rcpf(1.0f + __expf(-r[j])); r[j] = __logf(lb[j] + (1.0f - lb[j]) * sg); }
                        *(f32x4*)(LogF + off) = (f32x4){r[0], r[1], r[2], r[3]}; *(f32x4*)(LogF + off + 4) = (f32x4){r[4], r[5], r[6], r[7]};
                    }
                }
            }
    }
};

__device__ __forceinline__ float wave_sum(float v) {
#pragma unroll
    for (int o = 1; o < 64; o <<= 1) v += __shfl_xor(v, o);
    return v;
}
__device__ __forceinline__ void p0_transpose_item(const float* W, int K, int N, bf16_t* WT, const float* gain, int mode, int row_off, LAS float* scr, int item, int lane) {
    const int nblk = N / 32, kb = item / nblk, nb = item % nblk, k0 = 64 * kb, n0 = 32 * nb;
#pragma unroll 8
    for (int i = 0; i < 32; ++i) { const int kk = 2 * i + (lane >> 5); const float gsc = gain ? gain[k0 + kk] : 1.0f; scr[kk * 33 + (lane & 31)] = W[(size_t)(k0 + kk) * N + n0 + (lane & 31)] * gsc; }
    asm volatile("s_waitcnt lgkmcnt(0)" ::: "memory");
    const int c = lane & 7;
    const int rb = mode ? ((n0 >> 7) * 256 + (n0 & 127) + row_off) : n0;
#pragma unroll
    for (int j = 0; j < 4; ++j) { const int n = (lane >> 3) + 8 * j; const LAS float* s = scr + (8 * c) * 33 + n;
        u32x4 o; o.x = cvt_pk_bf16(s[0 * 33], s[1 * 33]); o.y = cvt_pk_bf16(s[2 * 33], s[3 * 33]); o.z = cvt_pk_bf16(s[4 * 33], s[5 * 33]); o.w = cvt_pk_bf16(s[6 * 33], s[7 * 33]);
        *(u32x4*)(WT + (size_t)(rb + n) * K + k0 + 8 * c) = o; }
    asm volatile("s_waitcnt lgkmcnt(0)" ::: "memory");
}

struct Args { const float* in[16]; float* out; unsigned char* ws; int ph_lo, ph_hi; };

__device__ __forceinline__ void attn_wave_item(int item, const bf16_t* Qsb, const bf16_t* Ksb, const bf16_t* VTsb, const float* gain, bf16_t* mixed, int lane) {
    const int bh = item >> 8, qb = item & 255, b = bh >> 3, h = bh & 7, q0 = qb * 16;
    const int fr = lane & 15, fq = lane >> 4, t = q0 + fr;
    const bf16_t* Qrow = Qsb + ((size_t)b * SEQ + t) * 512 + h * 64;
    bf16x8 qf[2];
    qf[0] = *(const bf16x8*)(Qrow + 8 * fq); qf[1] = *(const bf16x8*)(Qrow + 32 + 8 * fq);
    f32x4 o[4];
#pragma unroll
    for (int i = 0; i < 4; ++i) o[i] = (f32x4){0.f, 0.f, 0.f, 0.f};
    float carry = 0.f;
    const bf16_t* Kbase = Ksb + ((size_t)b * SEQ + fr) * 512 + h * 64 + 8 * fq;
    const bf16_t* Vbase = VTsb + ((size_t)b * 512 + h * 64 + fr) * SEQ + 4 * fq;
    for (int kt0 = q0 & ~63; kt0 >= 0; kt0 -= 64) {
        f32x4 z[4];
#pragma unroll
        for (int g = 0; g < 4; ++g) {
            const bf16_t* kp = Kbase + (size_t)(kt0 + 16 * g) * 512;
            const bf16x8 k0 = *(const bf16x8*)(kp), k1 = *(const bf16x8*)(kp + 32);
            z[g] = __builtin_amdgcn_mfma_f32_16x16x32_bf16(k0, qf[0], (f32x4){0.f, 0.f, 0.f, 0.f}, 0, 0, 0);
            z[g] = __builtin_amdgcn_mfma_f32_16x16x32_bf16(k1, qf[1], z[g], 0, 0, 0);
        }
        u32x2 vlo[4][2], vhi[4][2];
#pragma unroll
        for (int db = 0; db < 4; ++db)
#pragma unroll
            for (int s = 0; s < 2; ++s) { const bf16_t* vp = Vbase + (size_t)(16 * db) * SEQ + kt0 + 32 * s; vlo[db][s] = *(const u32x2*)(vp); vhi[db][s] = *(const u32x2*)(vp + 16); }
        float lr[4][4], lbt[4][4]; bool act[4][4];
#pragma unroll
        for (int g = 0; g < 4; ++g)
#pragma unroll
            for (int i = 0; i < 4; ++i) {
                const float zz = z[g][i];
                const float sp = fmaxf(zz, 0.f) + __logf(1.0f + __expf(-fabsf(zz)));
                act[g][i] = (kt0 + 16 * g + 4 * fq + i) < t;
                lr[g][i] = act[g][i] ? -sp : 0.f; lbt[g][i] = zz - sp;
            }
        float e[4][4], sg[4], T[4], X[4];
#pragma unroll
        for (int g = 0; g < 4; ++g) {
            e[g][3] = 0.f; e[g][2] = lr[g][3]; e[g][1] = e[g][2] + lr[g][2]; e[g][0] = e[g][1] + lr[g][1]; sg[g] = e[g][0] + lr[g][0];
            const float a1 = __shfl_xor(sg[g], 16), a2 = __shfl_xor(sg[g], 32), a3 = __shfl_xor(sg[g], 48);
            T[g] = (sg[g] + a1) + (a2 + a3);
            X[g] = ((fq ^ 1) > fq ? a1 : 0.f) + ((fq ^ 2) > fq ? a2 : 0.f) + ((fq ^ 3) > fq ? a3 : 0.f);
        }
        float G[4]; G[3] = 0.f; G[2] = T[3]; G[1] = G[2] + T[2]; G[0] = G[1] + T[1];
        const float total = G[0] + T[0];
        float w[4][4];
#pragma unroll
        for (int g = 0; g < 4; ++g)
#pragma unroll
            for (int i = 0; i < 4; ++i) { const float tail = carry + G[g] + X[g] + e[g][i]; w[g][i] = act[g][i] ? __expf(lbt[g][i] + tail) : 0.f; }
        carry += total;
#pragma unroll
        for (int s = 0; s < 2; ++s) {
            u32x4 wb; wb.x = cvt_pk_bf16(w[2 * s][0], w[2 * s][1]); wb.y = cvt_pk_bf16(w[2 * s][2], w[2 * s][3]); wb.z = cvt_pk_bf16(w[2 * s + 1][0], w[2 * s + 1][1]); wb.w = cvt_pk_bf16(w[2 * s + 1][2], w[2 * s + 1][3]);
            const bf16x8 wf = __builtin_bit_cast(bf16x8, wb);
#pragma unroll
            for (int db = 0; db < 4; ++db) {
                u32x4 va; va.x = vlo[db][s].x; va.y = vlo[db][s].y; va.z = vhi[db][s].x; va.w = vhi[db][s].y;
                o[db] = __builtin_amdgcn_mfma_f32_16x16x32_bf16(__builtin_bit_cast(bf16x8, va), wf, o[db], 0, 0, 0);
            }
        }
        if (!__any(carry >= -104.0f)) break;
    }
    float ss = 0.f;
#pragma unroll
    for (int db = 0; db < 4; ++db) ss += (o[db].x * o[db].x + o[db].y * o[db].y) + (o[db].z * o[db].z + o[db].w * o[db].w);
    ss += __shfl_xor(ss, 16); ss += __shfl_xor(ss, 32);
    const float rn = __builtin_amdgcn_rsqf(ss * (1.0f / 64.0f) + EPS);
    bf16_t* op = mixed + ((size_t)b * SEQ + t) * DM + h * 64 + 4 * fq;
#pragma unroll
    for (int db = 0; db < 4; ++db) {
        const f32x4 gn = *(const f32x4*)(gain + h * 64 + 16 * db + 4 * fq);
        u32x2 st; st.x = cvt_pk_bf16(o[db].x * rn * gn.x, o[db].y * rn * gn.y); st.y = cvt_pk_bf16(o[db].z * rn * gn.z, o[db].w * rn * gn.w);
#ifdef DBG_SKIP_SB
        st.x = 0u; st.y = 0u;
#endif
        *(u32x2*)(op + 16 * db) = st;
    }
}

constexpr int QE_P = 136, KS_P = 72;
__device__ __forceinline__ void hgrn_pass_a(LAS unsigned char* lds, int it, float* LogF, bf16_t* Qhg, const bf16_t* VThg, float* decay, bf16_t* LT) {
    const int tid = threadIdx.x, lane = tid & 63, w = __builtin_amdgcn_readfirstlane(tid >> 6), fr = lane & 15, fq = lane >> 4;
    const int bh = it >> 6, c = it & 63, b = bh >> 2, h = bh & 3;
    const size_t tok0 = (size_t)b * SEQ + 64 * c;
    LAS float* tot = (LAS float*)lds;
    LAS bf16_t* QE = (LAS bf16_t*)(lds + 2048);
    LAS bf16_t* KI = (LAS bf16_t*)(lds + 2048 + 64 * QE_P * 2);
    LAS bf16_t* KS = (LAS bf16_t*)(lds + 2048 + 2 * 64 * QE_P * 2);
    {
        const int d = tid & 127, part = tid >> 7;
        float lf[16], cs[16]; float run = 0.f;
        const float* lp = LogF + (tok0 + 16 * part) * 512 + h * 128 + d;
        bf16_t* qp = Qhg + (tok0 + 16 * part) * 512 + h * 128 + d;
        float qv[16];
#pragma unroll
        for (int i = 0; i < 16; ++i) { lf[i] = lp[(size_t)i * 512]; qv[i] = bf2f(qp[(size_t)i * 512]); }
#pragma unroll
        for (int i = 0; i < 16; ++i) { run += lf[i]; cs[i] = run; }
        tot[part * 128 + d] = run;
        __syncthreads();
        const float t0 = tot[d], t1 = tot[128 + d], t2 = tot[256 + d], t3 = tot[384 + d];
        const float off = (part > 0 ? t0 : 0.f) + (part > 1 ? t1 : 0.f) + (part > 2 ? t2 : 0.f);
        const float bl = (t0 + t1) + (t2 + t3);
#pragma unroll
        for (int i = 0; i < 16; ++i) {
            const int s = 16 * part + i; const float bb = off + cs[i];
            const float kk = 1.0f - __expf(lf[i]);
            const bf16_t qb = f2bf(qv[i] * __expf(bb));
            QE[s * QE_P + d] = qb; qp[(size_t)i * 512] = qb;
            KI[s * QE_P + d] = f2bf(kk * __expf(-bb));
            KS[d * KS_P + s] = f2bf(kk * __expf(bl - bb));
        }
        if (part == 0) decay[(size_t)it * 128 + d] = __expf(bl);
    }
    __syncthreads();
    {
        const int tblk = w & 3, vhalf = w >> 2;
        bf16x8 qf[4];
#pragma unroll
        for (int ks = 0; ks < 4; ++ks) qf[ks] = *(const LAS bf16x8*)(QE + (16 * tblk + fr) * QE_P + 32 * ks + 8 * fq);
        f32x4 sc[4];
#pragma unroll
        for (int sb = 0; sb < 4; ++sb) {
            sc[sb] = (f32x4){0.f, 0.f, 0.f, 0.f};
            if (sb <= tblk) {
#pragma unroll
                for (int ks = 0; ks < 4; ++ks) { const bf16x8 af = *(const LAS bf16x8*)(KI + (16 * sb + fr) * QE_P + 32 * ks + 8 * fq); sc[sb] = __builtin_amdgcn_mfma_f32_16x16x32_bf16(af, qf[ks], sc[sb], 0, 0, 0); }
            }
#pragma unroll
            for (int i = 0; i < 4; ++i) if (sb == tblk && (4 * fq + i) > fr) sc[sb][i] = 0.f;
        }
        bf16x8 pf[2];
#pragma unroll
        for (int p = 0; p < 2; ++p) { u32x4 wb; wb.x = cvt_pk_bf16(sc[2 * p][0], sc[2 * p][1]); wb.y = cvt_pk_bf16(sc[2 * p][2], sc[2 * p][3]); wb.z = cvt_pk_bf16(sc[2 * p + 1][0], sc[2 * p + 1][1]); wb.w = cvt_pk_bf16(sc[2 * p + 1][2], sc[2 * p + 1][3]); pf[p] = __builtin_bit_cast(bf16x8, wb); }
#pragma unroll
        for (int vb = 0; vb < 4; ++vb) {
            const int v = 64 * vhalf + 16 * vb + fr;
            const bf16_t* vp = VThg + ((size_t)bh * 128 + v) * SEQ + 64 * c + 4 * fq;
            f32x4 acc = (f32x4){0.f, 0.f, 0.f, 0.f};
#pragma unroll
            for (int p = 0; p < 2; ++p) if (2 * p <= tblk) {
                const u32x2 lo = *(const u32x2*)(vp + 32 * p), hi = *(const u32x2*)(vp + 32 * p + 16);
                u32x4 va; va.x = lo.x; va.y = lo.y; va.z = hi.x; va.w = hi.y;
                acc = __builtin_amdgcn_mfma_f32_16x16x32_bf16(__builtin_bit_cast(bf16x8, va), pf[p], acc, 0, 0, 0);
            }
            *(f32x4*)(LogF + (tok0 + 16 * tblk + fr) * 512 + h * 128 + 64 * vhalf + 16 * vb + 4 * fq) = acc;
        }
    }
    {
        bf16x8 af[2];
#pragma unroll
        for (int ks = 0; ks < 2; ++ks) af[ks] = *(const LAS bf16x8*)(KS + (16 * w + fr) * KS_P + 32 * ks + 8 * fq);
#pragma unroll
        for (int vb = 0; vb < 8; ++vb) {
            const int v = 16 * vb + fr;
            const bf16_t* vp = VThg + ((size_t)bh * 128 + v) * SEQ + 64 * c + 8 * fq;
            f32x4 acc = (f32x4){0.f, 0.f, 0.f, 0.f};
#pragma unroll
            for (int ks = 0; ks < 2; ++ks) { const bf16x8 bfr = *(const bf16x8*)(vp + 32 * ks); acc = __builtin_amdgcn_mfma_f32_16x16x32_bf16(af[ks], bfr, acc, 0, 0, 0); }
            u32x2 st; st.x = cvt_pk_bf16(acc.x, acc.y); st.y = cvt_pk_bf16(acc.z, acc.w);
            *(u32x2*)(LT + ((size_t)it * 128 + v) * 128 + 16 * w + 4 * fq) = st;
        }
    }
    __syncthreads();
}

__device__ __forceinline__ void hgrn_pass_c(int item, const float* OI, const bf16_t* Qe, const bf16_t* ST, const bf16_t* Ghg, const float* gain, bf16_t* mixed, int lane) {
    const int bh = item >> 8, c = (item >> 2) & 63, tblk = item & 3, b = bh >> 2, h = bh & 3;
    const int fr = lane & 15, fq = lane >> 4;
    const size_t tok = (size_t)b * SEQ + 64 * c + 16 * tblk + fr;
    bf16x8 qf[4];
#pragma unroll
    for (int ks = 0; ks < 4; ++ks) qf[ks] = *(const bf16x8*)(Qe + tok * 512 + h * 128 + 32 * ks + 8 * fq);
    f32x4 acc[8];
#pragma unroll
    for (int vb = 0; vb < 8; ++vb) acc[vb] = *(const f32x4*)(OI + tok * 512 + h * 128 + 16 * vb + 4 * fq);
    if (c > 0) {
        const bf16_t* sp = ST + ((size_t)(bh * 64 + c - 1) * 128 + fr) * 128 + 8 * fq;
#pragma unroll
        for (int vb = 0; vb < 8; ++vb)
#pragma unroll
            for (int ks = 0; ks < 4; ++ks) { const bf16x8 af = *(const bf16x8*)(sp + (size_t)(16 * vb) * 128 + 32 * ks); acc[vb] = __builtin_amdgcn_mfma_f32_16x16x32_bf16(af, qf[ks], acc[vb], 0, 0, 0); }
    }
    float ss = 0.f;
#pragma unroll
    for (int vb = 0; vb < 8; ++vb) ss += (acc[vb].x * acc[vb].x + acc[vb].y * acc[vb].y) + (acc[vb].z * acc[vb].z + acc[vb].w * acc[vb].w);
    ss += __shfl_xor(ss, 16); ss += __shfl_xor(ss, 32);
    const float rn = __builtin_amdgcn_rsqf(ss * (1.0f / 128.0f) + EPS);
#pragma unroll
    for (int vb = 0; vb < 8; ++vb) {
        const int col = h * 128 + 16 * vb + 4 * fq;
        const f32x4 gn = *(const f32x4*)(gain + col);
        const u32x2 gg = *(const u32x2*)(Ghg + tok * 512 + col);
        const float g0 = __uint_as_float(gg.x << 16), g1 = __uint_as_float(gg.x & 0xffff0000u), g2 = __uint_as_float(gg.y << 16), g3 = __uint_as_float(gg.y & 0xffff0000u);
        u32x2 st; st.x = cvt_pk_bf16(acc[vb].x * rn * gn.x * g0, acc[vb].y * rn * gn.y * g1); st.y = cvt_pk_bf16(acc[vb].z * rn * gn.z * g2, acc[vb].w * rn * gn.w * g3);
#ifdef DBG_SKIP_HG
        st.x = 0u; st.y = 0u;
#endif
        *(u32x2*)(mixed + tok * DM + 512 + col) = st;
    }
}

constexpr int LDS_BYTES = 131072 + 1024;
#define GRID_SYNC() do { asm volatile("s_waitcnt vmcnt(0) lgkmcnt(0)" ::: "memory"); grid.sync(); __builtin_amdgcn_fence(__ATOMIC_ACQUIRE, "agent"); asm volatile("s_waitcnt vmcnt(0)" ::: "memory"); } while (0)
#define PH(k) if (a.ph_lo <= (k) && (k) < a.ph_hi)
#define SEAM(k) do { if (a.ph_lo <= (k) && (k) + 1 < a.ph_hi) GRID_SYNC(); } while (0)
#ifndef DBG_NPH
#define DBG_NPH 11
#endif
#ifndef N_LAUNCHES
#define N_LAUNCHES 1
#endif
#define GEMM_PHASE(EpiT, Aptr, Bptr, Nn, Kk, Eobj) do { pg8::Gemm g_{(const bf16_t*)(Aptr), (const bf16_t*)(Bptr), NTOK, (Nn), (Kk)}; pg8::StaticOrder S_; S_.init(NTOK, (Nn), (int)gridDim.x, (int)blockIdx.x); \
    pg8::gemm_phase<EpiT, pg8::StaticOrder, true, true>(lds, g_, S_, (Eobj)); } while (0)

__global__ void __launch_bounds__(NTHR) fwd_kernel(Args a) {
    extern __shared__ __attribute__((aligned(16))) unsigned char lds_raw[];
    LAS unsigned char* lds = (LAS unsigned char*)lds_raw;
    cg::grid_group grid = cg::this_grid();
    const int tid = threadIdx.x, lane = tid & 63, wave = __builtin_amdgcn_readfirstlane(tid >> 6);
    const int gw = blockIdx.x * 8 + wave, NGW = gridDim.x * 8;
    unsigned char* ws = a.ws;
    unsigned* ctl = (unsigned*)(ws + WS_CTL);
    float* lbv = (float*)(ws + WS_LBV); float* decay = (float*)(ws + WS_DECAY);
    float* part0 = (float*)(ws + WS_PART0); float* part1 = (float*)(ws + WS_PART1); float* part2 = (float*)(ws + WS_PART2);
    bf16_t* W1gu = (bf16_t*)(ws + WS_W1GU); bf16_t* W1d = (bf16_t*)(ws + WS_W1D); bf16_t* Win = (bf16_t*)(ws + WS_WIN); bf16_t* Wout = (bf16_t*)(ws + WS_WOUT);
    bf16_t* W2gu = (bf16_t*)(ws + WS_W2GU); bf16_t* W2d = (bf16_t*)(ws + WS_W2D);
    bf16_t* XB = (bf16_t*)(ws + WS_XB); bf16_t* ACT = (bf16_t*)(ws + WS_ACT); bf16_t* XB2 = (bf16_t*)(ws + WS_XB2);
    bf16_t* Qsb = (bf16_t*)(ws + WS_QSB); bf16_t* Ksb = (bf16_t*)(ws + WS_KSB); bf16_t* VTsb = (bf16_t*)(ws + WS_VTSB);
    bf16_t* Qhg = (bf16_t*)(ws + WS_QHG); bf16_t* VThg = (bf16_t*)(ws + WS_VTHG); bf16_t* Ghg = (bf16_t*)(ws + WS_GHG);
    float* LogF = (float*)(ws + WS_LOGF); bf16_t* LT = (bf16_t*)(ws + WS_LT);
    bf16_t* MIXED = XB;
    const float* x = a.in[0]; float* out = a.out;

    PH(0) {
    {
        if (blockIdx.x == 0 && tid == 0) ctl[0] = 0u;
        if (blockIdx.x == 0) { const float* lg = a.in[8]; for (int c = tid; c < 512; c += NTHR) lbv[c] = 1.0f / (1.0f + __expf(lg[512 + c] - lg[c])); }
        LAS float* scr = (LAS float*)(lds + wave * 16384);
        constexpr int I_GU = 16 * 88, I_D = 44 * 32, I_IN = 16 * 112, I_OUT = 16 * 32;
        constexpr int NITEMS = 4 * I_GU + 2 * I_D + I_IN + I_OUT;
        for (int it = gw; it < NITEMS; it += NGW) {
            int r = it;
            if (r < I_GU) { p0_transpose_item(a.in[2], DM, DFF, W1gu, a.in[1], 1, 0, scr, r, lane); continue; } r -= I_GU;
            if (r < I_GU) { p0_transpose_item(a.in[3], DM, DFF, W1gu, a.in[1], 1, 128, scr, r, lane); continue; } r -= I_GU;
            if (r < I_D) { p0_transpose_item(a.in[4], DFF, DM, W1d, nullptr, 0, 0, scr, r, lane); continue; } r -= I_D;
            if (r < I_IN) { p0_transpose_item(a.in[6], DM, NIN, Win, a.in[5], 0, 0, scr, r, lane); continue; } r -= I_IN;
            if (r < I_OUT) { p0_transpose_item(a.in[10], DM, DM, Wout, nullptr, 0, 0, scr, r, lane); continue; } r -= I_OUT;
            if (r < I_GU) { p0_transpose_item(a.in[12], DM, DFF, W2gu, a.in[11], 1, 0, scr, r, lane); continue; } r -= I_GU;
            if (r < I_GU) { p0_transpose_item(a.in[13], DM, DFF, W2gu, a.in[11], 1, 128, scr, r, lane); continue; } r -= I_GU;
            p0_transpose_item(a.in[14], DFF, DM, W2d, nullptr, 0, 0, scr, r, lane);
        }
        for (int m = gw; m < NTOK; m += NGW) {
            const f32x4* xr = (const f32x4*)(x + (size_t)m * DM) + lane; f32x4 v[4]; float s = 0.f;
#pragma unroll
            for (int j = 0; j < 4; ++j) { v[j] = xr[64 * j]; s += (v[j].x * v[j].x + v[j].y * v[j].y) + (v[j].z * v[j].z + v[j].w * v[j].w); }
            s = wave_sum(s);
            u32x2* o8 = (u32x2*)(XB + (size_t)m * DM) + lane;
#pragma unroll
            for (int j = 0; j < 4; ++j) { u32x2 st; st.x = cvt_pk_bf16(v[j].x, v[j].y); st.y = cvt_pk_bf16(v[j].z, v[j].w); o8[64 * j] = st; }
            if (lane < 16) part0[(size_t)m * 16 + lane] = (lane == 0) ? s : 0.f;
        }
    }
    } SEAM(0); PH(1) {
    { EpiSwiglu E{ACT, part0}; GEMM_PHASE(EpiSwiglu, XB, W1gu, 2 * DFF, DM, E); }
    } SEAM(1); PH(2) {
    { EpiResid E{x, out, XB, part1, 0.5f}; GEMM_PHASE(EpiResid, ACT, W1d, DM, DFF, E); }
    } SEAM(2); PH(3) {
    { EpiMix E{part1, Qsb, Ksb, VTsb, Qhg, VThg, Ghg, LogF, lbv}; GEMM_PHASE(EpiMix, XB, Win, NIN, DM, E); }
    } SEAM(3); PH(4) {
    for (int it = blockIdx.x; it < 1024; it += gridDim.x) hgrn_pass_a(lds, it, LogF, Qhg, VThg, decay, LT);
    } SEAM(4); PH(5) {
    if (wave < 4) {
        for (int gid = blockIdx.x * 256 + tid; gid < 65536; gid += gridDim.x * 256) {
            const int bh = gid >> 12, v = (gid >> 5) & 127, d4 = (gid & 31) * 4;
            f32x4 S = (f32x4){0.f, 0.f, 0.f, 0.f};
            for (int c0 = 0; c0 < 64; c0 += 8) {
                f32x4 dec[8]; u32x2 l[8];
#pragma unroll
                for (int j = 0; j < 8; ++j) { dec[j] = *(const f32x4*)(decay + (size_t)(bh * 64 + c0 + j) * 128 + d4); l[j] = *(const u32x2*)(LT + ((size_t)(bh * 64 + c0 + j) * 128 + v) * 128 + d4); }
#pragma unroll
                for (int j = 0; j < 8; ++j) {
                    S.x = dec[j].x * S.x + __uint_as_float(l[j].x << 16); S.y = dec[j].y * S.y + __uint_as_float(l[j].x & 0xffff0000u);
                    S.z = dec[j].z * S.z + __uint_as_float(l[j].y << 16); S.w = dec[j].w * S.w + __uint_as_float(l[j].y & 0xffff0000u);
                    u32x2 st; st.x = cvt_pk_bf16(S.x, S.y); st.y = cvt_pk_bf16(S.z, S.w);
                    *(u32x2*)(LT + ((size_t)(bh * 64 + c0 + j) * 128 + v) * 128 + d4) = st;
                }
            }
        }
    }
    for (;;) {
        unsigned item = 0; if (lane == 0) item = atomicAdd(ctl, 1u);
        item = (unsigned)__builtin_amdgcn_readfirstlane((int)item);
        if (item >= 8192u) break;
        attn_wave_item((int)(8191u - item), Qsb, Ksb, VTsb, a.in[7], MIXED, lane);
    }
    } SEAM(5); PH(6) {
    for (int item = gw; item < 4096; item += NGW) hgrn_pass_c(item, LogF, Qhg, LT, Ghg, a.in[9], MIXED, lane);
    } SEAM(6); PH(7) {
    { EpiResid E{out, out, XB2, part2, 1.0f}; GEMM_PHASE(EpiResid, MIXED, Wout, DM, DM, E); }
    } SEAM(7); PH(8) {
    { EpiSwiglu E{ACT, part2}; GEMM_PHASE(EpiSwiglu, XB2, W2gu, 2 * DFF, DM, E); }
    } SEAM(8); PH(9) {
    { EpiResid E{out, out, nullptr, nullptr, 0.5f}; GEMM_PHASE(EpiResid, ACT, W2d, DM, DFF, E); }
    } SEAM(9); PH(10) {
    {
        const float* fg = a.in[15];
        for (int m = gw; m < NTOK; m += NGW) {
            f32x4* xr = (f32x4*)(out + (size_t)m * DM) + lane; f32x4 v[4]; float s = 0.f;
#pragma unroll
            for (int j = 0; j < 4; ++j) { v[j] = xr[64 * j]; s += (v[j].x * v[j].x + v[j].y * v[j].y) + (v[j].z * v[j].z + v[j].w * v[j].w); }
            s = wave_sum(s);
            const float rn = __builtin_amdgcn_rsqf(s * (1.0f / 1024.0f) + EPS);
#pragma unroll
            for (int j = 0; j < 4; ++j) { const f32x4 g = *((const f32x4*)fg + lane + 64 * j); xr[64 * j] = v[j] * rn * g; }
        }
    }
    }
}

extern "C" void kernel_launch(void* const* d_in, const int* in_sizes, int n_in, void* d_out, int out_size, void* d_ws, size_t ws_size, hipStream_t stream) {
    static int grid = 0;
    if (grid == 0) {
        if (n_in != 16 || out_size != NTOK * DM || ws_size < WS_END) { fprintf(stderr, "kernel_launch: unexpected problem shape (n_in %d, out %d, ws %zu)\n", n_in, out_size, ws_size); grid = -1; return; }
        int dev = 0, cus = 0, per_cu = 0;
        hipGetDevice(&dev); hipDeviceGetAttribute(&cus, hipDeviceAttributeMultiprocessorCount, dev);
        hipFuncSetAttribute((const void*)fwd_kernel, hipFuncAttributeMaxDynamicSharedMemorySize, LDS_BYTES);
        hipOccupancyMaxActiveBlocksPerMultiprocessor(&per_cu, (const void*)fwd_kernel, NTHR, LDS_BYTES);
        if (per_cu < 1) per_cu = 1;
        grid = cus * per_cu;
        (void)hipGetLastError();
    }
    if (grid < 0) return;
    Args a{};
    for (int i = 0; i < 16; ++i) a.in[i] = (const float*)d_in[i];
    a.out = (float*)d_out; a.ws = (unsigned char*)d_ws;
    hipError_t e = hipSuccess;
    if (N_LAUNCHES == 1) {
        a.ph_lo = 0; a.ph_hi = 11;
        void* args[] = {&a};
        e = hipLaunchCooperativeKernel((const void*)fwd_kernel, dim3(grid), dim3(NTHR), args, LDS_BYTES, stream);
    } else {
        for (int ph = 0; ph < DBG_NPH; ++ph) { a.ph_lo = ph; a.ph_hi = ph + 1; hipLaunchKernelGGL(fwd_kernel, dim3(grid), dim3(NTHR), LDS_BYTES, stream, a); }
        e = hipPeekAtLastError();
    }
    if (e != hipSuccess) fprintf(stderr, "launch failed: %s (grid %d)\n", hipGetErrorString(e), grid);
}
```

```cpp
#include <hip/hip_runtime.h>
#include <hip/hip_cooperative_groups.h>
#include <cstdio>
#include <cstdint>
namespace cg = cooperative_groups;
namespace pg8 {
#define PG8_LAS __attribute__((address_space(3)))
typedef unsigned short bf16_t;
typedef short bf16x8 __attribute__((ext_vector_type(8)));
typedef float f32x4 __attribute__((ext_vector_type(4)));
typedef unsigned u32x4 __attribute__((ext_vector_type(4)));
constexpr int BM = 256, BK = 64, HALF = 128, HTB = HALF * BK * 2  , STAGE_BYTES = 8 * HTB, NXCD = 8, WGM = 8;

__host__ __device__ __forceinline__ int lds_byte(int r, int c) { const int st = (r >> 4) * 2 + (c >> 5), rr = r & 15, cc = c & 31, ob = rr * 64 + cc * 2; return st * 1024 + (ob ^ (((ob >> 9) & 1) << 5)); }
__host__ __device__ __forceinline__ void stage_rc(int b, int& R, int& C) { const int st = b / 1024, sb = b % 1024, swz = sb ^ (((sb >> 9) & 1) << 5); R = (st >> 1) * 16 + swz / 64; C = (st & 1) * 32 + (swz % 64) / 2; }
__host__ __device__ __forceinline__ int perm32(int rho) { const int n = rho >> 4, i = rho & 15; return 8 * (i >> 2) + 4 * n + (i & 3); }

struct Unit { int pm, pn; };
struct Gemm { const bf16_t* A; const bf16_t* Bt; int M, N, K; };

struct StaticOrder {
    int nM, nN, nwg, G, c;
    __host__ __device__ void init(int M, int N, int G_, int c_) { nM = M / BM; nN = N / BM; nwg = nM * nN; G = G_; c = c_; }
    __host__ __device__ bool next(int i, Unit& u) const {
        const long L = (long)i * G + c; if (L >= nwg) return false;
        int wgid = (int)L; { const int q = nwg / NXCD, r = nwg % NXCD, xcd = wgid % NXCD, off = wgid / NXCD; wgid = (xcd < r ? xcd * (q + 1) : r * (q + 1) + (xcd - r) * q) + off; }
        const int nig = WGM * nN, gid = wgid / nig, fm = gid * WGM, gsz = (nM - fm) < WGM ? (nM - fm) : WGM;
        u.pm = fm + ((wgid % nig) % gsz); u.pn = (wgid % nig) / gsz; return true;
    }
    __device__ __forceinline__ void a_ready(const Unit&) const {}
    __device__ __forceinline__ void done(const Unit&) const {}
};
__device__ __forceinline__ unsigned cvt_pk_bf16(float lo, float hi) { unsigned r; asm volatile("v_cvt_pk_bf16_f32 %0, %1, %2" : "=v"(r) : "v"(lo), "v"(hi)); return r; }
typedef float f32x2 __attribute__((ext_vector_type(2)));
template <class Epi, class Sched, bool ALIGN_EPI = false, bool SP2 = false>
__device__ __forceinline__ void gemm_phase(PG8_LAS unsigned char* lds, const Gemm g, const Sched& S, const Epi& E) {
    const int tid = threadIdx.x, wid = __builtin_amdgcn_readfirstlane(tid >> 6), lane = tid & 63, wr = wid >> 2, wc = wid & 3, fr = lane & 15, fq = lane >> 4;
    const int K = g.K, nt = K / BK;
    unsigned voffA[2], voffB[2];
#pragma unroll
    for (int i = 0; i < 2; ++i) { int R, C; stage_rc(tid * 16 + i * 8192, R, C); const int Rb = Epi::PERM ? ((R & ~31) + perm32(R & 31)) : R;
        voffA[i] = (unsigned)(R * K + C) * 2u; voffB[i] = (unsigned)(Rb * K + C) * 2u; }
    const size_t kstep = (size_t)(BK * 2);
    const size_t hstep = (size_t)HALF * K * 2;
    const size_t tstep = 2 * hstep;
    const unsigned ldsw = (unsigned)wid * 1024u;
    const int aoff = lds_byte(wr * 64 + fr, fq * 8), boff = lds_byte(wc * 32 + fr, fq * 8);
#define PG8_SA(b, h) (((b) * 2 + (h)) * HTB)
#define PG8_SB(b, h) ((4 + (b) * 2 + (h)) * HTB)
#define PG8_STAGE(bufoff, gbase, voff) do { _Pragma("unroll") for (int _i = 0; _i < 2; ++_i) \
        __builtin_amdgcn_global_load_lds((const unsigned*)((const char*)(gbase) + (voff)[_i]), (PG8_LAS unsigned*)(lds + (bufoff) + ldsw + _i * 8192), 16, 0, 0); } while (0)
#define PG8_LDA(dst, b, h) do { _Pragma("unroll") for (int m = 0; m < 4; ++m) _Pragma("unroll") for (int k = 0; k < 2; ++k) dst[m][k] = *(const PG8_LAS bf16x8*)(lds + PG8_SA(b, h) + aoff + m * 2048 + k * 1024); } while (0)
#define PG8_LDB(dst, b, h) do { _Pragma("unroll") for (int n = 0; n < 2; ++n) _Pragma("unroll") for (int k = 0; k < 2; ++k) dst[n][k] = *(const PG8_LAS bf16x8*)(lds + PG8_SB(b, h) + boff + n * 2048 + k * 1024); } while (0)
#define PG8_MMA(ai, bj, At, Bt) do { __builtin_amdgcn_s_setprio(1); _Pragma("unroll") for (int m = 0; m < 4; ++m) _Pragma("unroll") for (int n = 0; n < 2; ++n) _Pragma("unroll") for (int k = 0; k < 2; ++k) \
        acc[ai][bj][m][n] = __builtin_amdgcn_mfma_f32_16x16x32_bf16(Bt[n][k], At[m][k], acc[ai][bj][m][n], 0, 0, 0); __builtin_amdgcn_s_setprio(0); } while (0)
#define PG8_WAIT_V(n) asm volatile("s_waitcnt vmcnt(" #n ")" ::: "memory")
#define PG8_WAIT_L(n) asm volatile("s_waitcnt lgkmcnt(" #n ")" ::: "memory")
#define PG8_BAR __builtin_amdgcn_s_barrier()
#define PG8_SCHED __builtin_amdgcn_sched_barrier(0)
    Unit cur, nxt; int ui = 0;
    if (!S.next(0, cur)) return;
    f32x4 acc[2][2][4][2];
#pragma unroll
    for (int a = 0; a < 2; ++a)
#pragma unroll
        for (int b = 0; b < 2; ++b)
#pragma unroll
            for (int m = 0; m < 4; ++m)
#pragma unroll
                for (int n = 0; n < 2; ++n) acc[a][b][m][n] = (f32x4){0.f, 0.f, 0.f, 0.f};
    bf16x8 At[4][2], B0[2][2], B1[2][2];
    const char* cA = (const char*)g.A + (size_t)cur.pm * tstep; const char* cB = (const char*)g.Bt + (size_t)cur.pn * tstep;
    S.a_ready(cur);
    if constexpr (SP2) {
        PG8_STAGE(PG8_SB(0, 0), cB, voffB); PG8_STAGE(PG8_SB(0, 1), cB + hstep, voffB); PG8_STAGE(PG8_SA(0, 0), cA, voffA); PG8_STAGE(PG8_SA(0, 1), cA + hstep, voffA);
        if (wr == 1) PG8_BAR;
        PG8_WAIT_V(2); PG8_BAR;
        PG8_STAGE(PG8_SB(1, 0), cB + kstep, voffB); PG8_STAGE(PG8_SA(1, 0), cA + kstep, voffA); PG8_STAGE(PG8_SB(1, 1), cB + hstep + kstep, voffB);
        PG8_WAIT_V(6); PG8_BAR;
    } else {
        PG8_STAGE(PG8_SB(0, 0), cB, voffB); PG8_STAGE(PG8_SA(0, 0), cA, voffA); PG8_STAGE(PG8_SB(0, 1), cB + hstep, voffB); PG8_STAGE(PG8_SA(0, 1), cA + hstep, voffA);
        if (wr == 1) PG8_BAR;
        PG8_WAIT_V(4); PG8_BAR;
        PG8_STAGE(PG8_SB(1, 0), cB + kstep, voffB); PG8_STAGE(PG8_SA(1, 0), cA + kstep, voffA); PG8_STAGE(PG8_SB(1, 1), cB + hstep + kstep, voffB);
        PG8_WAIT_V(6); PG8_BAR;
    }
    for (;;) {
        const bool has_next = S.next(ui + 1, nxt);
        const char* nA = has_next ? (const char*)g.A + (size_t)nxt.pm * tstep : cA; const char* nB = has_next ? (const char*)g.Bt + (size_t)nxt.pn * tstep : cB;
        for (int t = 0; t < nt; t += 2) {
            const bool last = (t == nt - 2);
            const char* a1 = cA + (size_t)(t + 1) * kstep;
            const char* a2 = last ? nA : cA + (size_t)(t + 2) * kstep; const char* b2 = last ? nB : cB + (size_t)(t + 2) * kstep;
            const char* a3 = a2 + kstep; const char* b3 = b2 + kstep;
            if (last && has_next) S.a_ready(nxt);
            if constexpr (SP2) {
            PG8_LDB(B0, 0, 0); PG8_LDB(B1, 0, 1); PG8_SCHED; PG8_LDA(At, 0, 0); PG8_STAGE(PG8_SA(1, 1), a1 + hstep, voffA);
            PG8_WAIT_V(8); PG8_WAIT_L(0); PG8_BAR; PG8_MMA(0, 0, At, B0); PG8_MMA(0, 1, At, B1); PG8_BAR; PG8_SCHED;
            PG8_LDA(At, 0, 1); PG8_STAGE(PG8_SB(0, 0), b2, voffB); PG8_STAGE(PG8_SB(0, 1), b2 + hstep, voffB); PG8_STAGE(PG8_SA(0, 0), a2, voffA);
            PG8_WAIT_V(8); PG8_WAIT_L(0); PG8_BAR; PG8_MMA(1, 0, At, B0); PG8_MMA(1, 1, At, B1); PG8_BAR; PG8_SCHED;
            PG8_LDB(B0, 1, 0); PG8_LDB(B1, 1, 1); PG8_SCHED; PG8_LDA(At, 1, 0); PG8_STAGE(PG8_SA(0, 1), a2 + hstep, voffA);
            PG8_WAIT_V(8); PG8_WAIT_L(0); PG8_BAR; PG8_MMA(0, 0, At, B0); PG8_MMA(0, 1, At, B1); PG8_BAR; PG8_SCHED;
            PG8_LDA(At, 1, 1); PG8_STAGE(PG8_SB(1, 0), b3, voffB); PG8_STAGE(PG8_SB(1, 1), b3 + hstep, voffB); PG8_STAGE(PG8_SA(1, 0), a3, voffA);
            PG8_WAIT_V(8); PG8_WAIT_L(0); PG8_BAR; PG8_MMA(1, 0, At, B0); PG8_MMA(1, 1, At, B1); PG8_BAR; PG8_SCHED;
            } else {
            PG8_LDB(B0, 0, 0); PG8_SCHED; PG8_LDA(At, 0, 0); PG8_STAGE(PG8_SA(1, 1), a1 + hstep, voffA);
            PG8_WAIT_L(8); PG8_BAR; PG8_WAIT_L(0); PG8_MMA(0, 0, At, B0); PG8_BAR; PG8_SCHED;
            PG8_LDB(B1, 0, 1); PG8_STAGE(PG8_SB(0, 0), b2, voffB);
            PG8_BAR; PG8_WAIT_L(0); PG8_MMA(0, 1, At, B1); PG8_BAR;
            PG8_LDA(At, 0, 1); PG8_STAGE(PG8_SA(0, 0), a2, voffA);
            PG8_BAR; PG8_WAIT_L(0); PG8_MMA(1, 0, At, B0); PG8_BAR; PG8_SCHED;
            PG8_STAGE(PG8_SB(0, 1), b2 + hstep, voffB);
            PG8_WAIT_V(6); PG8_BAR; PG8_MMA(1, 1, At, B1); PG8_BAR;
            PG8_LDB(B0, 1, 0); PG8_SCHED; PG8_LDA(At, 1, 0); PG8_STAGE(PG8_SA(0, 1), a2 + hstep, voffA);
            PG8_WAIT_L(8); PG8_BAR; PG8_WAIT_L(0); PG8_MMA(0, 0, At, B0); PG8_BAR; PG8_SCHED;
            PG8_LDB(B1, 1, 1); PG8_STAGE(PG8_SB(1, 0), b3, voffB);
            PG8_BAR; PG8_WAIT_L(0); PG8_MMA(0, 1, At, B1); PG8_BAR;
            PG8_LDA(At, 1, 1); PG8_STAGE(PG8_SA(1, 0), a3, voffA);
            PG8_BAR; PG8_WAIT_L(0); PG8_MMA(1, 0, At, B0); PG8_BAR; PG8_SCHED;
            PG8_STAGE(PG8_SB(1, 1), b3 + hstep, voffB);
            PG8_WAIT_V(6); PG8_BAR; PG8_MMA(1, 1, At, B1); PG8_BAR;
            }
        }
        if constexpr (ALIGN_EPI) { if (wr == 0) PG8_BAR; }
        if constexpr (!Epi::AFTER_DRAIN) { E(acc, cur, wr, wc, fr, fq); S.done(cur); }
        if (!has_next) break;
#pragma unroll
        for (int a = 0; a < 2; ++a)
#pragma unroll
            for (int b = 0; b < 2; ++b)
#pragma unroll
                for (int m = 0; m < 4; ++m)
#pragma unroll
                    for (int n = 0; n < 2; ++n) acc[a][b][m][n] = (f32x4){0.f, 0.f, 0.f, 0.f};
        cur = nxt; cA = nA; cB = nB; ++ui;
        if constexpr (ALIGN_EPI) { if (wr == 1) PG8_BAR; }
    }
    PG8_WAIT_V(0);
    if constexpr (!ALIGN_EPI) { if (wr == 0) PG8_BAR; }
    PG8_BAR;
    if constexpr (Epi::AFTER_DRAIN) { E.fused(acc, cur, wr, wc, fr, fq, lds, wid, lane); S.done(cur); }
#undef PG8_SA
#undef PG8_SB
#undef PG8_STAGE
#undef PG8_LDA
#undef PG8_LDB
#undef PG8_MMA
#undef PG8_WAIT_V
#undef PG8_WAIT_L
#undef PG8_BAR
#undef PG8_SCHED
}
}
#define LAS __attribute__((address_space(3)))
#define XB_TMO      128
#define XB_XCNT(j)  (256  + 64 * (j))
#define XB_XSUB(j)  (1280 + 64 * (j))
#define XB_XGEN(j)  (2304 + 64 * (j))
#define XB_TOP      3328
#define XB_TOPGEN   3392
#define XCD_BAR_WORDS 3456
#define XB_SPIN_CAP (1u << 18)

__device__ __forceinline__ unsigned xb_ld(unsigned* p)              { return __hip_atomic_load(p, __ATOMIC_RELAXED, __HIP_MEMORY_SCOPE_AGENT); }
__device__ __forceinline__ unsigned xb_add(unsigned* p, unsigned v) { return __hip_atomic_fetch_add(p, v, __ATOMIC_RELAXED, __HIP_MEMORY_SCOPE_AGENT); }
__device__ __forceinline__ unsigned xb_xcc_id() { return (unsigned)__builtin_amdgcn_s_getreg((3 << 11) | 20) & 0xFu; }
#define XB_SPIN(cond, bar) do { unsigned _sp = 0; while (cond) { __builtin_amdgcn_s_sleep(1); \
    if ((++_sp & 255u) == 0u) { if (xb_ld(&(bar)[XB_TMO])) break; if (_sp > XB_SPIN_CAP) { atomicAdd(&(bar)[XB_TMO], 1u); break; } } } } while (0)

struct XcdBarrier {
    unsigned* bar; unsigned x;
    volatile LAS unsigned* st;
};

__device__ __forceinline__ XcdBarrier xcd_barrier_post(unsigned* bar, volatile LAS unsigned* st) {
    XcdBarrier b; b.bar = bar; b.x = xb_xcc_id(); b.st = st;
    if (threadIdx.x == 0) (void)xb_add(&bar[XB_XCNT(b.x)], 1u);
    return b;
}
__device__ __forceinline__ void xcd_barrier_complete(unsigned* bar, unsigned x, unsigned& nloc, unsigned& nx) {
    const unsigned G = gridDim.x * gridDim.y * gridDim.z;
    unsigned sum, cnt, mine, sp = 0u;
    for (;;) {
        sum = 0u; cnt = 0u; mine = 0u;
#pragma unroll
        for (unsigned j = 0; j < 16; ++j) { const unsigned c = xb_ld(&bar[XB_XCNT(j)]); sum += c; cnt += (c > 0u) ? 1u : 0u; mine = (j == x) ? c : mine; }
        if (sum == G) break;
        __builtin_amdgcn_s_sleep(1);
        if ((++sp & 255u) == 0u) { if (xb_ld(&bar[XB_TMO])) break; if (sp > XB_SPIN_CAP) { atomicAdd(&bar[XB_TMO], 1u); break; } }
    }
    nloc = mine > 0u ? mine : 1u; nx = cnt > 0u ? cnt : 1u;
}

__device__ __forceinline__ void xcd_barrier(const XcdBarrier& b) {
    asm volatile("s_waitcnt vmcnt(0)" ::: "memory");
    __syncthreads();
    if (threadIdx.x == 0) {
        unsigned* bar = b.bar;
        __builtin_amdgcn_s_waitcnt(0);
        unsigned nloc = b.st[0], nx = b.st[1];
        if (nloc == 0u) { xcd_barrier_complete(bar, b.x, nloc, nx); b.st[0] = nloc; b.st[1] = nx; }
        const unsigned old = xb_add(&bar[XB_XSUB(b.x)], 1u);
        const unsigned gen = old / nloc;
        if (old + 1u == (gen + 1u) * nloc) {
            __builtin_amdgcn_fence(__ATOMIC_RELEASE, "agent");
            asm volatile("s_waitcnt vmcnt(0)" ::: "memory");
            const unsigned og = xb_add(&bar[XB_TOP], 1u);
            const unsigned tg = og / nx;
            if (og + 1u == (tg + 1u) * nx) xb_add(&bar[XB_TOPGEN], 1u);
            else XB_SPIN(xb_ld(&bar[XB_TOPGEN]) == tg, bar);
            __builtin_amdgcn_fence(__ATOMIC_ACQUIRE, "agent");
            xb_add(&bar[XB_XGEN(b.x)], 1u);
            asm volatile("s_waitcnt vmcnt(0)" ::: "memory");
        } else {
            XB_SPIN(xb_ld(&bar[XB_XGEN(b.x)]) == gen, bar);
            __builtin_amdgcn_fence(__ATOMIC_ACQUIRE, "agent");
            asm volatile("s_waitcnt vmcnt(0)" ::: "memory");
        }
    }
    __syncthreads();
}
using pg8::bf16_t; using pg8::bf16x8; using pg8::f32x4; using pg8::u32x4; using pg8::Unit;
typedef float f32x2_t __attribute__((ext_vector_type(2))); typedef __bf16 bf16x2_t __attribute__((ext_vector_type(2)));
__device__ __forceinline__ unsigned cvt_pk_bf16(float lo, float hi) { f32x2_t v = {lo, hi}; bf16x2_t b = __builtin_convertvector(v, bf16x2_t); return __builtin_bit_cast(unsigned, b); }
typedef unsigned u32x2 __attribute__((ext_vector_type(2)));
#define LAS __attribute__((address_space(3)))

constexpr int NTOK = 16384, DM = 1024, DFF = 2816, SEQ = 4096, NIN = 3584, NTHR = 512;
constexpr float EPS = 1e-6f;
constexpr size_t MiB = 1u << 20;
constexpr size_t WS_CTL = 0, WS_LBV = 64 * 1024, WS_DECAY = 1 * MiB, WS_PART0 = 2 * MiB, WS_PART1 = 3 * MiB, WS_PART2 = 4 * MiB;
constexpr size_t WS_W1GU = 6 * MiB, WS_W1D = 17 * MiB, WS_WIN = 22 * MiB + MiB / 2, WS_WOUT = 29 * MiB + MiB / 2, WS_W2GU = 31 * MiB + MiB / 2, WS_W2D = 42 * MiB + MiB / 2;
constexpr size_t WS_XB = 48 * MiB;
constexpr size_t WS_ACT = 80 * MiB;
constexpr size_t WS_QSB = 80 * MiB, WS_KSB = 96 * MiB, WS_VTSB = 112 * MiB, WS_QHG = 128 * MiB, WS_VTHG = 144 * MiB, WS_GHG = 160 * MiB;
constexpr size_t WS_LOGF = 176 * MiB;
constexpr size_t WS_LT = 208 * MiB;
constexpr size_t WS_XB2 = 176 * MiB;
constexpr size_t WS_END = 240 * MiB;

__device__ __forceinline__ float bf2f(unsigned short u) { return __uint_as_float((unsigned)u << 16); }
__device__ __forceinline__ bf16_t f2bf(float x) { return (bf16_t)(cvt_pk_bf16(x, 0.f) & 0xffffu); }
__device__ __forceinline__ float silu_f(float v) { return v * __builtin_amdgcn_rcpf(1.0f + __expf(-v)); }
__device__ __forceinline__ u32x4 pack8(const float* r) { u32x4 w; w.x = cvt_pk_bf16(r[0], r[1]); w.y = cvt_pk_bf16(r[2], r[3]); w.z = cvt_pk_bf16(r[4], r[5]); w.w = cvt_pk_bf16(r[6], r[7]); return w; }
__device__ __forceinline__ float row_rs(const float* part, int row, int fq) {
    const f32x4 p = *(const f32x4*)(part + (size_t)row * 16 + 4 * fq);
    float s = (p.x + p.y) + (p.z + p.w);
    s += __shfl_xor(s, 16); s += __shfl_xor(s, 32);
    return __builtin_amdgcn_rsqf(s * (1.0f / 1024.0f) + EPS);
}

struct EpiSwiglu {
    static constexpr bool PERM = true, AFTER_DRAIN = false;
    bf16_t* O; const float* part;
    __device__ __forceinline__ void operator()(const f32x4 (&acc)[2][2][4][2], const Unit& u, int wr, int wc, int fr, int fq) const {
        const int row0 = u.pm * 256 + wr * 64 + fr, col0 = u.pn * 128 + wc * 32 + 8 * fq;
#pragma unroll
        for (int ai = 0; ai < 2; ++ai)
#pragma unroll
            for (int m = 0; m < 4; ++m) {
                const int row = row0 + ai * 128 + m * 16;
                const float rs = row_rs(part, row, fq);
                float r[8];
#pragma unroll
                for (int n = 0; n < 2; ++n)
#pragma unroll
                    for (int j = 0; j < 4; ++j) { const float g = acc[ai][0][m][n][j] * rs, uu = acc[ai][1][m][n][j] * rs; r[n * 4 + j] = silu_f(g) * uu; }
                *(u32x4*)(O + (size_t)row * DFF + col0) = pack8(r);
            }
    }
};
struct EpiResid {
    static constexpr bool PERM = true, AFTER_DRAIN = false;
    const float* base; float* out; bf16_t* ob; float* part; float alpha;
    __device__ __forceinline__ void operator()(const f32x4 (&acc)[2][2][4][2], const Unit& u, int wr, int wc, int fr, int fq) const {
        const int row0 = u.pm * 256 + wr * 64 + fr, col0 = u.pn * 256 + wc * 32 + 8 * fq;
#pragma unroll
        for (int ai = 0; ai < 2; ++ai)
#pragma unroll
            for (int m = 0; m < 4; ++m) {
                const int row = row0 + ai * 128 + m * 16; float ss = 0.f;
#pragma unroll
                for (int bj = 0; bj < 2; ++bj) {
                    const size_t off = (size_t)row * DM + col0 + bj * 128;
                    const f32x4 b0 = *(const f32x4*)(base + off), b1 = *(const f32x4*)(base + off + 4);
                    const f32x4 v0 = b0 + acc[ai][bj][m][0] * alpha, v1 = b1 + acc[ai][bj][m][1] * alpha;
                    *(f32x4*)(out + off) = v0; *(f32x4*)(out + off + 4) = v1;
                    ss += (v0.x * v0.x + v0.y * v0.y) + (v0.z * v0.z + v0.w * v0.w) + (v1.x * v1.x + v1.y * v1.y) + (v1.z * v1.z + v1.w * v1.w);
                    if (ob) { const float r[8] = {v0.x, v0.y, v0.z, v0.w, v1.x, v1.y, v1.z, v1.w}; *(u32x4*)(ob + off) = pack8(r); }
                }
                if (part) { ss += __shfl_xor(ss, 16); ss += __shfl_xor(ss, 32); if (fq == 0) part[(size_t)row * 16 + u.pn * 4 + wc] = ss; }
            }
    }
};
struct EpiMix {
    static constexpr bool PERM = true, AFTER_DRAIN = false;
    const float* part; bf16_t *Qsb, *Ksb, *VTsb, *Qhg, *VThg, *Ghg; float* LogF; const float* lbv;
    __device__ __forceinline__ void operator()(const f32x4 (&acc)[2][2][4][2], const Unit& u, int wr, int wc, int fr, int fq) const {
        const int typ = u.pn >> 1;
        const int row0 = u.pm * 256 + wr * 64 + fr, cg0 = (u.pn & 1) * 256 + wc * 32 + 8 * fq;
#pragma unroll
        for (int ai = 0; ai < 2; ++ai)
#pragma unroll
            for (int m = 0; m < 4; ++m) {
                const int row = row0 + ai * 128 + m * 16;
                const float rs = row_rs(part, row, fq);
#pragma unroll
                for (int bj = 0; bj < 2; ++bj) {
                    const int cg = cg0 + bj * 128;
                    float r[8];
#pragma unroll
                    for (int n = 0; n < 2; ++n)
#pragma unroll
                        for (int j = 0; j < 4; ++j) r[n * 4 + j] = acc[ai][bj][m][n][j] * rs;
                    const size_t off = (size_t)row * 512 + cg;
                    if (typ == 0) {
#pragma unroll
                        for (int j = 0; j < 8; ++j) r[j] *= 0.125f;
                        *(u32x4*)(Qsb + off) = pack8(r);
                    } else if (typ == 1) {
                        *(u32x4*)(Ksb + off) = pack8(r);
                    } else if (typ == 2 || typ == 5) {
                        bf16_t* dst = (typ == 2 ? VTsb : VThg) + ((size_t)(row >> 12) * 512 + cg) * SEQ + (row & (SEQ - 1));
#pragma unroll
                        for (int j = 0; j < 8; ++j) dst[(size_t)j * SEQ] = f2bf(r[j]);
                    } else if (typ == 3 || typ == 6) {
#pragma unroll
                        for (int j = 0; j < 8; ++j) r[j] = silu_f(r[j]);
                        *(u32x4*)((typ == 3 ? Qhg : Ghg) + off) = pack8(r);
                    } else {
                        const f32x4 l0 = *(const f32x4*)(lbv + cg), l1 = *(const f32x4*)(lbv + cg + 4);
                        const float lb[8] = {l0.x, l0.y, l0.z, l0.w, l1.x, l1.y, l1.z, l1.w};
#pragma unroll
                        for (int j = 0; j < 8; ++j) { const float sg = __builtin_amdgcn_rcpf(1.0f + __expf(-r[j])); r[j] = __logf(lb[j] + (1.0f - lb[j]) * sg); }
                        *(f32x4*)(LogF + off) = (f32x4){r[0], r[1], r[2], r[3]}; *(f32x4*)(LogF + off + 4) = (f32x4){r[4], r[5], r[6], r[7]};
                    }
                }
            }
    }
};

__device__ __forceinline__ float wave_sum(float v) {
#pragma unroll
    for (int o = 1; o < 64; o <<= 1) v += __shfl_xor(v, o);
    return v;
}
__device__ __forceinline__ void p0_transpose_item(const float* W, int K, int N, bf16_t* WT, const float* gain, int mode, int row_off, LAS float* scr, int item, int lane) {
    const int nblk = N / 32, kb = item / nblk, nb = item % nblk, k0 = 64 * kb, n0 = 32 * nb;
#pragma unroll 8
    for (int i = 0; i < 32; ++i) { const int kk = 2 * i + (lane >> 5); const float gsc = gain ? gain[k0 + kk] : 1.0f; scr[kk * 33 + (lane & 31)] = W[(size_t)(k0 + kk) * N + n0 + (lane & 31)] * gsc; }
    asm volatile("s_waitcnt lgkmcnt(0)" ::: "memory");
    const int c = lane & 7;
    const int rb = mode ? ((n0 >> 7) * 256 + (n0 & 127) + row_off) : n0;
#pragma unroll
    for (int j = 0; j < 4; ++j) { const int n = (lane >> 3) + 8 * j; const LAS float* s = scr + (8 * c) * 33 + n;
        u32x4 o; o.x = cvt_pk_bf16(s[0 * 33], s[1 * 33]); o.y = cvt_pk_bf16(s[2 * 33], s[3 * 33]); o.z = cvt_pk_bf16(s[4 * 33], s[5 * 33]); o.w = cvt_pk_bf16(s[6 * 33], s[7 * 33]);
        *(u32x4*)(WT + (size_t)(rb + n) * K + k0 + 8 * c) = o; }
    asm volatile("s_waitcnt lgkmcnt(0)" ::: "memory");
}

struct Args { const float* in[16]; float* out; unsigned char* ws; int ph_lo, ph_hi; };

__device__ __forceinline__ void attn_wave_item(int item, const bf16_t* Qsb, const bf16_t* Ksb, const bf16_t* VTsb, const float* gain, bf16_t* mixed, int lane) {
    const int bh = item >> 8, qb = item & 255, b = bh >> 3, h = bh & 7, q0 = qb * 16;
    const int fr = lane & 15, fq = lane >> 4, t = q0 + fr;
    const bf16_t* Qrow = Qsb + ((size_t)b * SEQ + t) * 512 + h * 64;
    bf16x8 qf[2];
    qf[0] = *(const bf16x8*)(Qrow + 8 * fq); qf[1] = *(const bf16x8*)(Qrow + 32 + 8 * fq);
    f32x4 o[4];
#pragma unroll
    for (int i = 0; i < 4; ++i) o[i] = (f32x4){0.f, 0.f, 0.f, 0.f};
    float carry = 0.f;
    const bf16_t* Kbase = Ksb + ((size_t)b * SEQ + fr) * 512 + h * 64 + 8 * fq;
    const bf16_t* Vbase = VTsb + ((size_t)b * 512 + h * 64 + fr) * SEQ + 4 * fq;
    for (int kt0 = q0 & ~63; kt0 >= 0; kt0 -= 64) {
        f32x4 z[4];
#pragma unroll
        for (int g = 0; g < 4; ++g) {
            const bf16_t* kp = Kbase + (size_t)(kt0 + 16 * g) * 512;
            const bf16x8 k0 = *(const bf16x8*)(kp), k1 = *(const bf16x8*)(kp + 32);
            z[g] = __builtin_amdgcn_mfma_f32_16x16x32_bf16(k0, qf[0], (f32x4){0.f, 0.f, 0.f, 0.f}, 0, 0, 0);
            z[g] = __builtin_amdgcn_mfma_f32_16x16x32_bf16(k1, qf[1], z[g], 0, 0, 0);
        }
        u32x2 vlo[4][2], vhi[4][2];
#pragma unroll
        for (int db = 0; db < 4; ++db)
#pragma unroll
            for (int s = 0; s < 2; ++s) { const bf16_t* vp = Vbase + (size_t)(16 * db) * SEQ + kt0 + 32 * s; vlo[db][s] = *(const u32x2*)(vp); vhi[db][s] = *(const u32x2*)(vp + 16); }
        float lr[4][4], lbt[4][4]; bool act[4][4];
#pragma unroll
        for (int g = 0; g < 4; ++g)
#pragma unroll
            for (int i = 0; i < 4; ++i) {
                const float zz = z[g][i];
                const float sp = fmaxf(zz, 0.f) + __logf(1.0f + __expf(-fabsf(zz)));
                act[g][i] = (kt0 + 16 * g + 4 * fq + i) < t;
                lr[g][i] = act[g][i] ? -sp : 0.f; lbt[g][i] = zz - sp;
            }
        float e[4][4], sg[4], T[4], X[4];
#pragma unroll
        for (int g = 0; g < 4; ++g) {
            e[g][3] = 0.f; e[g][2] = lr[g][3]; e[g][1] = e[g][2] + lr[g][2]; e[g][0] = e[g][1] + lr[g][1]; sg[g] = e[g][0] + lr[g][0];
            const float a1 = __shfl_xor(sg[g], 16), a2 = __shfl_xor(sg[g], 32), a3 = __shfl_xor(sg[g], 48);
            T[g] = (sg[g] + a1) + (a2 + a3);
            X[g] = ((fq ^ 1) > fq ? a1 : 0.f) + ((fq ^ 2) > fq ? a2 : 0.f) + ((fq ^ 3) > fq ? a3 : 0.f);
        }
        float G[4]; G[3] = 0.f; G[2] = T[3]; G[1] = G[2] + T[2]; G[0] = G[1] + T[1];
        const float total = G[0] + T[0];
        float w[4][4];
#pragma unroll
        for (int g = 0; g < 4; ++g)
#pragma unroll
            for (int i = 0; i < 4; ++i) { const float tail = carry + G[g] + X[g] + e[g][i]; w[g][i] = act[g][i] ? __expf(lbt[g][i] + tail) : 0.f; }
        carry += total;
#pragma unroll
        for (int s = 0; s < 2; ++s) {
            u32x4 wb; wb.x = cvt_pk_bf16(w[2 * s][0], w[2 * s][1]); wb.y = cvt_pk_bf16(w[2 * s][2], w[2 * s][3]); wb.z = cvt_pk_bf16(w[2 * s + 1][0], w[2 * s + 1][1]); wb.w = cvt_pk_bf16(w[2 * s + 1][2], w[2 * s + 1][3]);
            const bf16x8 wf = __builtin_bit_cast(bf16x8, wb);
#pragma unroll
            for (int db = 0; db < 4; ++db) {
                u32x4 va; va.x = vlo[db][s].x; va.y = vlo[db][s].y; va.z = vhi[db][s].x; va.w = vhi[db][s].y;
                o[db] = __builtin_amdgcn_mfma_f32_16x16x32_bf16(__builtin_bit_cast(bf16x8, va), wf, o[db], 0, 0, 0);
            }
        }
        if (!__any(carry >= -104.0f)) break;
    }
    float ss = 0.f;
#pragma unroll
    for (int db = 0; db < 4; ++db) ss += (o[db].x * o[db].x + o[db].y * o[db].y) + (o[db].z * o[db].z + o[db].w * o[db].w);
    ss += __shfl_xor(ss, 16); ss += __shfl_xor(ss, 32);
    const float rn = __builtin_amdgcn_rsqf(ss * (1.0f / 64.0f) + EPS);
    bf16_t* op = mixed + ((size_t)b * SEQ + t) * DM + h * 64 + 4 * fq;
#pragma unroll
    for (int db = 0; db < 4; ++db) {
        const f32x4 gn = *(const f32x4*)(gain + h * 64 + 16 * db + 4 * fq);
        u32x2 st; st.x = cvt_pk_bf16(o[db].x * rn * gn.x, o[db].y * rn * gn.y); st.y = cvt_pk_bf16(o[db].z * rn * gn.z, o[db].w * rn * gn.w);
#ifdef DBG_SKIP_SB
        st.x = 0u; st.y = 0u;
#endif
        *(u32x2*)(op + 16 * db) = st;
    }
}

constexpr int QE_P = 136, KS_P = 72;
__device__ __forceinline__ void hgrn_pass_a(LAS unsigned char* lds, int it, float* LogF, bf16_t* Qhg, const bf16_t* VThg, float* decay, bf16_t* LT) {
    const int tid = threadIdx.x, lane = tid & 63, w = __builtin_amdgcn_readfirstlane(tid >> 6), fr = lane & 15, fq = lane >> 4;
    const int bh = it >> 6, c = it & 63, b = bh >> 2, h = bh & 3;
    const size_t tok0 = (size_t)b * SEQ + 64 * c;
    LAS float* tot = (LAS float*)lds;
    LAS bf16_t* QE = (LAS bf16_t*)(lds + 2048);
    LAS bf16_t* KI = (LAS bf16_t*)(lds + 2048 + 64 * QE_P * 2);
    LAS bf16_t* KS = (LAS bf16_t*)(lds + 2048 + 2 * 64 * QE_P * 2);
    {
        const int d = tid & 127, part = tid >> 7;
        float lf[16], cs[16]; float run = 0.f;
        const float* lp = LogF + (tok0 + 16 * part) * 512 + h * 128 + d;
        bf16_t* qp = Qhg + (tok0 + 16 * part) * 512 + h * 128 + d;
        float qv[16];
#pragma unroll
        for (int i = 0; i < 16; ++i) { lf[i] = lp[(size_t)i * 512]; qv[i] = bf2f(qp[(size_t)i * 512]); }
#pragma unroll
        for (int i = 0; i < 16; ++i) { run += lf[i]; cs[i] = run; }
        tot[part * 128 + d] = run;
        __syncthreads();
        const float t0 = tot[d], t1 = tot[128 + d], t2 = tot[256 + d], t3 = tot[384 + d];
        const float off = (part > 0 ? t0 : 0.f) + (part > 1 ? t1 : 0.f) + (part > 2 ? t2 : 0.f);
        const float bl = (t0 + t1) + (t2 + t3);
#pragma unroll
        for (int i = 0; i < 16; ++i) {
            const int s = 16 * part + i; const float bb = off + cs[i];
            const float kk = 1.0f - __expf(lf[i]);
            const bf16_t qb = f2bf(qv[i] * __expf(bb));
            QE[s * QE_P + d] = qb; qp[(size_t)i * 512] = qb;
            KI[s * QE_P + d] = f2bf(kk * __expf(-bb));
            KS[d * KS_P + s] = f2bf(kk * __expf(bl - bb));
        }
        if (part == 0) decay[(size_t)it * 128 + d] = __expf(bl);
    }
    __syncthreads();
    {
        const int tblk = w & 3, vhalf = w >> 2;
        bf16x8 qf[4];
#pragma unroll
        for (int ks = 0; ks < 4; ++ks) qf[ks] = *(const LAS bf16x8*)(QE + (16 * tblk + fr) * QE_P + 32 * ks + 8 * fq);
        f32x4 sc[4];
#pragma unroll
        for (int sb = 0; sb < 4; ++sb) {
            sc[sb] = (f32x4){0.f, 0.f, 0.f, 0.f};
            if (sb <= tblk) {
#pragma unroll
                for (int ks = 0; ks < 4; ++ks) { const bf16x8 af = *(const LAS bf16x8*)(KI + (16 * sb + fr) * QE_P + 32 * ks + 8 * fq); sc[sb] = __builtin_amdgcn_mfma_f32_16x16x32_bf16(af, qf[ks], sc[sb], 0, 0, 0); }
            }
#pragma unroll
            for (int i = 0; i < 4; ++i) if (sb == tblk && (4 * fq + i) > fr) sc[sb][i] = 0.f;
        }
        bf16x8 pf[2];
#pragma unroll
        for (int p = 0; p < 2; ++p) { u32x4 wb; wb.x = cvt_pk_bf16(sc[2 * p][0], sc[2 * p][1]); wb.y = cvt_pk_bf16(sc[2 * p][2], sc[2 * p][3]); wb.z = cvt_pk_bf16(sc[2 * p + 1][0], sc[2 * p + 1][1]); wb.w = cvt_pk_bf16(sc[2 * p + 1][2], sc[2 * p + 1][3]); pf[p] = __builtin_bit_cast(bf16x8, wb); }
#pragma unroll
        for (int vb = 0; vb < 4; ++vb) {
            const int v = 64 * vhalf + 16 * vb + fr;
            const bf16_t* vp = VThg + ((size_t)bh * 128 + v) * SEQ + 64 * c + 4 * fq;
            f32x4 acc = (f32x4){0.f, 0.f, 0.f, 0.f};
#pragma unroll
            for (int p = 0; p < 2; ++p) if (2 * p <= tblk) {
                const u32x2 lo = *(const u32x2*)(vp + 32 * p), hi = *(const u32x2*)(vp + 32 * p + 16);
                u32x4 va; va.x = lo.x; va.y = lo.y; va.z = hi.x; va.w = hi.y;
                acc = __builtin_amdgcn_mfma_f32_16x16x32_bf16(__builtin_bit_cast(bf16x8, va), pf[p], acc, 0, 0, 0);
            }
            *(f32x4*)(LogF + (tok0 + 16 * tblk + fr) * 512 + h * 128 + 64 * vhalf + 16 * vb + 4 * fq) = acc;
        }
    }
    {
        bf16x8 af[2];
#pragma unroll
        for (int ks = 0; ks < 2; ++ks) af[ks] = *(const LAS bf16x8*)(KS + (16 * w + fr) * KS_P + 32 * ks + 8 * fq);
#pragma unroll
        for (int vb = 0; vb < 8; ++vb) {
            const int v = 16 * vb + fr;
            const bf16_t* vp = VThg + ((size_t)bh * 128 + v) * SEQ + 64 * c + 8 * fq;
            f32x4 acc = (f32x4){0.f, 0.f, 0.f, 0.f};
#pragma unroll
            for (int ks = 0; ks < 2; ++ks) { const bf16x8 bfr = *(const bf16x8*)(vp + 32 * ks); acc = __builtin_amdgcn_mfma_f32_16x16x32_bf16(af[ks], bfr, acc, 0, 0, 0); }
            u32x2 st; st.x = cvt_pk_bf16(acc.x, acc.y); st.y = cvt_pk_bf16(acc.z, acc.w);
            *(u32x2*)(LT + ((size_t)it * 128 + v) * 128 + 16 * w + 4 * fq) = st;
        }
    }
    __syncthreads();
}

__device__ __forceinline__ void hgrn_pass_c(int item, const float* OI, const bf16_t* Qe, const bf16_t* ST, const bf16_t* Ghg, const float* gain, bf16_t* mixed, int lane) {
    const int bh = item >> 8, c = (item >> 2) & 63, tblk = item & 3, b = bh >> 2, h = bh & 3;
    const int fr = lane & 15, fq = lane >> 4;
    const size_t tok = (size_t)b * SEQ + 64 * c + 16 * tblk + fr;
    bf16x8 qf[4];
#pragma unroll
    for (int ks = 0; ks < 4; ++ks) qf[ks] = *(const bf16x8*)(Qe + tok * 512 + h * 128 + 32 * ks + 8 * fq);
    f32x4 acc[8];
#pragma unroll
    for (int vb = 0; vb < 8; ++vb) acc[vb] = *(const f32x4*)(OI + tok * 512 + h * 128 + 16 * vb + 4 * fq);
    if (c > 0) {
        const bf16_t* sp = ST + ((size_t)(bh * 64 + c - 1) * 128 + fr) * 128 + 8 * fq;
#pragma unroll
        for (int vb = 0; vb < 8; ++vb)
#pragma unroll
            for (int ks = 0; ks < 4; ++ks) { const bf16x8 af = *(const bf16x8*)(sp + (size_t)(16 * vb) * 128 + 32 * ks); acc[vb] = __builtin_amdgcn_mfma_f32_16x16x32_bf16(af, qf[ks], acc[vb], 0, 0, 0); }
    }
    float ss = 0.f;
#pragma unroll
    for (int vb = 0; vb < 8; ++vb) ss += (acc[vb].x * acc[vb].x + acc[vb].y * acc[vb].y) + (acc[vb].z * acc[vb].z + acc[vb].w * acc[vb].w);
    ss += __shfl_xor(ss, 16); ss += __shfl_xor(ss, 32);
    const float rn = __builtin_amdgcn_rsqf(ss * (1.0f / 128.0f) + EPS);
#pragma unroll
    for (int vb = 0; vb < 8; ++vb) {
        const int col = h * 128 + 16 * vb + 4 * fq;
        const f32x4 gn = *(const f32x4*)(gain + col);
        const u32x2 gg = *(const u32x2*)(Ghg + tok * 512 + col);
        const float g0 = __uint_as_float(gg.x << 16), g1 = __uint_as_float(gg.x & 0xffff0000u), g2 = __uint_as_float(gg.y << 16), g3 = __uint_as_float(gg.y & 0xffff0000u);
        u32x2 st; st.x = cvt_pk_bf16(acc[vb].x * rn * gn.x * g0, acc[vb].y * rn * gn.y * g1); st.y = cvt_pk_bf16(acc[vb].z * rn * gn.z * g2, acc[vb].w * rn * gn.w * g3);
#ifdef DBG_SKIP_HG
        st.x = 0u; st.y = 0u;
#endif
        *(u32x2*)(mixed + tok * DM + 512 + col) = st;
    }
}

constexpr int LDS_BYTES = 131072 + 1024;
constexpr int CW_BAR = 1024;
#define GRID_SYNC0() do { asm volatile("s_waitcnt vmcnt(0) lgkmcnt(0)" ::: "memory"); grid.sync(); \
    if (wave == 0) { __builtin_amdgcn_fence(__ATOMIC_ACQUIRE, "agent"); asm volatile("s_waitcnt vmcnt(0)" ::: "memory"); } __syncthreads(); } while (0)
#define PH(k) if (a.ph_lo <= (k) && (k) < a.ph_hi)
#define SEAM(k) do { if (a.ph_lo <= (k) && (k) + 1 < a.ph_hi) { if ((k) == 0) { GRID_SYNC0(); xbar = xcd_barrier_post(ctl + CW_BAR, (volatile LAS unsigned*)(lds + 131072 + 64)); } else xcd_barrier(xbar); } } while (0)
#ifndef DBG_NPH
#define DBG_NPH 11
#endif
#ifndef N_LAUNCHES
#define N_LAUNCHES 1
#endif
#define GEMM_PHASE(EpiT, Aptr, Bptr, Nn, Kk, Eobj) do { pg8::Gemm g_{(const bf16_t*)(Aptr), (const bf16_t*)(Bptr), NTOK, (Nn), (Kk)}; pg8::StaticOrder S_; S_.init(NTOK, (Nn), (int)gridDim.x, (int)blockIdx.x); \
    pg8::gemm_phase<EpiT, pg8::StaticOrder, true, true>(lds, g_, S_, (Eobj)); } while (0)

__global__ void __launch_bounds__(NTHR) fwd_kernel(Args a) {
    extern __shared__ __attribute__((aligned(16))) unsigned char lds_raw[];
    LAS unsigned char* lds = (LAS unsigned char*)lds_raw;
    cg::grid_group grid = cg::this_grid();
    const int tid = threadIdx.x, lane = tid & 63, wave = __builtin_amdgcn_readfirstlane(tid >> 6);
    const int gw = blockIdx.x * 8 + wave, NGW = gridDim.x * 8;
    unsigned char* ws = a.ws;
    unsigned* ctl = (unsigned*)(ws + WS_CTL);
    float* lbv = (float*)(ws + WS_LBV); float* decay = (float*)(ws + WS_DECAY);
    float* part0 = (float*)(ws + WS_PART0); float* part1 = (float*)(ws + WS_PART1); float* part2 = (float*)(ws + WS_PART2);
    bf16_t* W1gu = (bf16_t*)(ws + WS_W1GU); bf16_t* W1d = (bf16_t*)(ws + WS_W1D); bf16_t* Win = (bf16_t*)(ws + WS_WIN); bf16_t* Wout = (bf16_t*)(ws + WS_WOUT);
    bf16_t* W2gu = (bf16_t*)(ws + WS_W2GU); bf16_t* W2d = (bf16_t*)(ws + WS_W2D);
    bf16_t* XB = (bf16_t*)(ws + WS_XB); bf16_t* ACT = (bf16_t*)(ws + WS_ACT); bf16_t* XB2 = (bf16_t*)(ws + WS_XB2);
    bf16_t* Qsb = (bf16_t*)(ws + WS_QSB); bf16_t* Ksb = (bf16_t*)(ws + WS_KSB); bf16_t* VTsb = (bf16_t*)(ws + WS_VTSB);
    bf16_t* Qhg = (bf16_t*)(ws + WS_QHG); bf16_t* VThg = (bf16_t*)(ws + WS_VTHG); bf16_t* Ghg = (bf16_t*)(ws + WS_GHG);
    float* LogF = (float*)(ws + WS_LOGF); bf16_t* LT = (bf16_t*)(ws + WS_LT);
    bf16_t* MIXED = XB;
    const float* x = a.in[0]; float* out = a.out;
    if (tid < 2) ((LAS unsigned*)(lds + 131072 + 64))[tid] = 0u;
    __syncthreads();
    XcdBarrier xbar; xbar.bar = ctl + CW_BAR; xbar.x = 0; xbar.st = nullptr;

    PH(0) {
    {
        if (blockIdx.x == 0) { if (tid == 0) ctl[0] = 0u; for (int i = tid; i < XCD_BAR_WORDS; i += NTHR) ctl[CW_BAR + i] = 0u; }
        if (blockIdx.x == 0) { const float* lg = a.in[8]; for (int c = tid; c < 512; c += NTHR) lbv[c] = 1.0f / (1.0f + __expf(lg[512 + c] - lg[c])); }
        LAS float* scr = (LAS float*)(lds + wave * 16384);
        constexpr int I_GU = 16 * 88, I_D = 44 * 32, I_IN = 16 * 112, I_OUT = 16 * 32;
        constexpr int NITEMS = 4 * I_GU + 2 * I_D + I_IN + I_OUT;
        for (int it = gw; it < NITEMS; it += NGW) {
            int r = it;
            if (r < I_GU) { p0_transpose_item(a.in[2], DM, DFF, W1gu, a.in[1], 1, 0, scr, r, lane); continue; } r -= I_GU;
            if (r < I_GU) { p0_transpose_item(a.in[3], DM, DFF, W1gu, a.in[1], 1, 128, scr, r, lane); continue; } r -= I_GU;
            if (r < I_D) { p0_transpose_item(a.in[4], DFF, DM, W1d, nullptr, 0, 0, scr, r, lane); continue; } r -= I_D;
            if (r < I_IN) { p0_transpose_item(a.in[6], DM, NIN, Win, a.in[5], 0, 0, scr, r, lane); continue; } r -= I_IN;
            if (r < I_OUT) { p0_transpose_item(a.in[10], DM, DM, Wout, nullptr, 0, 0, scr, r, lane); continue; } r -= I_OUT;
            if (r < I_GU) { p0_transpose_item(a.in[12], DM, DFF, W2gu, a.in[11], 1, 0, scr, r, lane); continue; } r -= I_GU;
            if (r < I_GU) { p0_transpose_item(a.in[13], DM, DFF, W2gu, a.in[11], 1, 128, scr, r, lane); continue; } r -= I_GU;
            p0_transpose_item(a.in[14], DFF, DM, W2d, nullptr, 0, 0, scr, r, lane);
        }
        for (int m = gw; m < NTOK; m += NGW) {
            const f32x4* xr = (const f32x4*)(x + (size_t)m * DM) + lane; f32x4 v[4]; float s = 0.f;
#pragma unroll
            for (int j = 0; j < 4; ++j) { v[j] = xr[64 * j]; s += (v[j].x * v[j].x + v[j].y * v[j].y) + (v[j].z * v[j].z + v[j].w * v[j].w); }
            s = wave_sum(s);
            u32x2* o8 = (u32x2*)(XB + (size_t)m * DM) + lane;
#pragma unroll
            for (int j = 0; j < 4; ++j) { u32x2 st; st.x = cvt_pk_bf16(v[j].x, v[j].y); st.y = cvt_pk_bf16(v[j].z, v[j].w); o8[64 * j] = st; }
            if (lane < 16) part0[(size_t)m * 16 + lane] = (lane == 0) ? s : 0.f;
        }
    }
    } SEAM(0); PH(1) {
    { EpiSwiglu E{ACT, part0}; GEMM_PHASE(EpiSwiglu, XB, W1gu, 2 * DFF, DM, E); }
    } SEAM(1); PH(2) {
    { EpiResid E{x, out, XB, part1, 0.5f}; GEMM_PHASE(EpiResid, ACT, W1d, DM, DFF, E); }
    } SEAM(2); PH(3) {
    { EpiMix E{part1, Qsb, Ksb, VTsb, Qhg, VThg, Ghg, LogF, lbv}; GEMM_PHASE(EpiMix, XB, Win, NIN, DM, E); }
    } SEAM(3); PH(4) {
    for (int it = blockIdx.x; it < 1024; it += gridDim.x) hgrn_pass_a(lds, it, LogF, Qhg, VThg, decay, LT);
    } SEAM(4); PH(5) {
    if (wave < 4) {
        for (int gid = blockIdx.x * 256 + tid; gid < 65536; gid += gridDim.x * 256) {
            const int bh = gid >> 12, v = (gid >> 5) & 127, d4 = (gid & 31) * 4;
            f32x4 S = (f32x4){0.f, 0.f, 0.f, 0.f};
            for (int c0 = 0; c0 < 64; c0 += 8) {
                f32x4 dec[8]; u32x2 l[8];
#pragma unroll
                for (int j = 0; j < 8; ++j) { dec[j] = *(const f32x4*)(decay + (size_t)(bh * 64 + c0 + j) * 128 + d4); l[j] = *(const u32x2*)(LT + ((size_t)(bh * 64 + c0 + j) * 128 + v) * 128 + d4); }
#pragma unroll
                for (int j = 0; j < 8; ++j) {
                    S.x = dec[j].x * S.x + __uint_as_float(l[j].x << 16); S.y = dec[j].y * S.y + __uint_as_float(l[j].x & 0xffff0000u);
                    S.z = dec[j].z * S.z + __uint_as_float(l[j].y << 16); S.w = dec[j].w * S.w + __uint_as_float(l[j].y & 0xffff0000u);
                    u32x2 st; st.x = cvt_pk_bf16(S.x, S.y); st.y = cvt_pk_bf16(S.z, S.w);
                    *(u32x2*)(LT + ((size_t)(bh * 64 + c0 + j) * 128 + v) * 128 + d4) = st;
                }
            }
        }
    }
    for (;;) {
        unsigned item = 0; if (lane == 0) item = atomicAdd(ctl, 1u);
        item = (unsigned)__builtin_amdgcn_readfirstlane((int)item);
        if (item >= 8192u) break;
        attn_wave_item((int)(8191u - item), Qsb, Ksb, VTsb, a.in[7], MIXED, lane);
    }
    } SEAM(5); PH(6) {
    for (int item = gw; item < 4096; item += NGW) hgrn_pass_c(item, LogF, Qhg, LT, Ghg, a.in[9], MIXED, lane);
    } SEAM(6); PH(7) {
    { EpiResid E{out, out, XB2, part2, 1.0f}; GEMM_PHASE(EpiResid, MIXED, Wout, DM, DM, E); }
    } SEAM(7); PH(8) {
    { EpiSwiglu E{ACT, part2}; GEMM_PHASE(EpiSwiglu, XB2, W2gu, 2 * DFF, DM, E); }
    } SEAM(8); PH(9) {
    { EpiResid E{out, out, nullptr, nullptr, 0.5f}; GEMM_PHASE(EpiResid, ACT, W2d, DM, DFF, E); }
    } SEAM(9); PH(10) {
    {
        const float* fg = a.in[15];
        for (int m = gw; m < NTOK; m += NGW) {
            f32x4* xr = (f32x4*)(out + (size_t)m * DM) + lane; f32x4 v[4]; float s = 0.f;
#pragma unroll
            for (int j = 0; j < 4; ++j) { v[j] = xr[64 * j]; s += (v[j].x * v[j].x + v[j].y * v[j].y) + (v[j].z * v[j].z + v[j].w * v[j].w); }
            s = wave_sum(s);
            const float rn = __builtin_amdgcn_rsqf(s * (1.0f / 1024.0f) + EPS);
#pragma unroll
            for (int j = 0; j < 4; ++j) { const f32x4 g = *((const f32x4*)fg + lane + 64 * j); xr[64 * j] = v[j] * rn * g; }
        }
    }
    }
}

extern "C" void kernel_launch(void* const* d_in, const int* in_sizes, int n_in, void* d_out, int out_size, void* d_ws, size_t ws_size, hipStream_t stream) {
    static int grid = 0;
    if (grid == 0) {
        if (n_in != 16 || out_size != NTOK * DM || ws_size < WS_END) { fprintf(stderr, "kernel_launch: unexpected problem shape (n_in %d, out %d, ws %zu)\n", n_in, out_size, ws_size); grid = -1; return; }
        int dev = 0, cus = 0, per_cu = 0;
        hipGetDevice(&dev); hipDeviceGetAttribute(&cus, hipDeviceAttributeMultiprocessorCount, dev);
        hipFuncSetAttribute((const void*)fwd_kernel, hipFuncAttributeMaxDynamicSharedMemorySize, LDS_BYTES);
        hipOccupancyMaxActiveBlocksPerMultiprocessor(&per_cu, (const void*)fwd_kernel, NTHR, LDS_BYTES);
        if (per_cu < 1) per_cu = 1;
        grid = cus * per_cu;
        (void)hipGetLastError();
    }
    if (grid < 0) return;
    Args a{};
    for (int i = 0; i < 16; ++i) a.in[i] = (const float*)d_in[i];
    a.out = (float*)d_out; a.ws = (unsigned char*)d_ws;
    hipError_t e = hipSuccess;
    if (N_LAUNCHES == 1) {
        a.ph_lo = 0; a.ph_hi = 11;
        void* args[] = {&a};
        e = hipLaunchCooperativeKernel((const void*)fwd_kernel, dim3(grid), dim3(NTHR), args, LDS_BYTES, stream);
    } else {
        for (int ph = 0; ph < DBG_NPH; ++ph) { a.ph_lo = ph; a.ph_hi = ph + 1; hipLaunchKernelGGL(fwd_kernel, dim3(grid), dim3(NTHR), LDS_BYTES, stream, a); }
        e = hipPeekAtLastError();
    }
    if (e != hipSuccess) fprintf(stderr, "launch failed: %s (grid %d)\n", hipGetErrorString(e), grid);
}
```

```cpp
#include <hip/hip_runtime.h>
#include <hip/hip_cooperative_groups.h>
#include <cstdio>
#include <cstdint>
namespace cg = cooperative_groups;
namespace pg8 {
#define PG8_LAS __attribute__((address_space(3)))
typedef unsigned short bf16_t;
typedef short bf16x8 __attribute__((ext_vector_type(8)));
typedef float f32x4 __attribute__((ext_vector_type(4)));
typedef unsigned u32x4 __attribute__((ext_vector_type(4)));
constexpr int BM = 256, BK = 64, HALF = 128, HTB = HALF * BK * 2  , STAGE_BYTES = 8 * HTB, NXCD = 8, WGM = 8;

__host__ __device__ __forceinline__ int lds_byte(int r, int c) { const int st = (r >> 4) * 2 + (c >> 5), rr = r & 15, cc = c & 31, ob = rr * 64 + cc * 2; return st * 1024 + (ob ^ (((ob >> 9) & 1) << 5)); }
__host__ __device__ __forceinline__ void stage_rc(int b, int& R, int& C) { const int st = b / 1024, sb = b % 1024, swz = sb ^ (((sb >> 9) & 1) << 5); R = (st >> 1) * 16 + swz / 64; C = (st & 1) * 32 + (swz % 64) / 2; }
__host__ __device__ __forceinline__ int perm32(int rho) { const int n = rho >> 4, i = rho & 15; return 8 * (i >> 2) + 4 * n + (i & 3); }

struct Unit { int pm, pn; };
struct Gemm { const bf16_t* A; const bf16_t* Bt; int M, N, K; };

struct StaticOrder {
    int nM, nN, nwg, G, c;
    __host__ __device__ void init(int M, int N, int G_, int c_) { nM = M / BM; nN = N / BM; nwg = nM * nN; G = G_; c = c_; }
    __host__ __device__ bool next(int i, Unit& u) const {
        const long L = (long)i * G + c; if (L >= nwg) return false;
        int wgid = (int)L; { const int q = nwg / NXCD, r = nwg % NXCD, xcd = wgid % NXCD, off = wgid / NXCD; wgid = (xcd < r ? xcd * (q + 1) : r * (q + 1) + (xcd - r) * q) + off; }
        const int nig = WGM * nN, gid = wgid / nig, fm = gid * WGM, gsz = (nM - fm) < WGM ? (nM - fm) : WGM;
        u.pm = fm + ((wgid % nig) % gsz); u.pn = (wgid % nig) / gsz; return true;
    }
    __device__ __forceinline__ void a_ready(const Unit&) const {}
    __device__ __forceinline__ void done(const Unit&) const {}
};
__device__ __forceinline__ unsigned cvt_pk_bf16(float lo, float hi) { unsigned r; asm volatile("v_cvt_pk_bf16_f32 %0, %1, %2" : "=v"(r) : "v"(lo), "v"(hi)); return r; }
typedef float f32x2 __attribute__((ext_vector_type(2)));
template <class Epi, class Sched, bool ALIGN_EPI = false, bool SP2 = false>
__device__ __forceinline__ void gemm_phase(PG8_LAS unsigned char* lds, const Gemm g, const Sched& S, const Epi& E) {
    const int tid = threadIdx.x, wid = __builtin_amdgcn_readfirstlane(tid >> 6), lane = tid & 63, wr = wid >> 2, wc = wid & 3, fr = lane & 15, fq = lane >> 4;
    const int K = g.K, nt = K / BK;
    unsigned voffA[2], voffB[2];
#pragma unroll
    for (int i = 0; i < 2; ++i) { int R, C; stage_rc(tid * 16 + i * 8192, R, C); const int Rb = Epi::PERM ? ((R & ~31) + perm32(R & 31)) : R;
        voffA[i] = (unsigned)(R * K + C) * 2u; voffB[i] = (unsigned)(Rb * K + C) * 2u; }
    const size_t kstep = (size_t)(BK * 2);
    const size_t hstep = (size_t)HALF * K * 2;
    const size_t tstep = 2 * hstep;
    const unsigned ldsw = (unsigned)wid * 1024u;
    const int aoff = lds_byte(wr * 64 + fr, fq * 8), boff = lds_byte(wc * 32 + fr, fq * 8);
#define PG8_SA(b, h) (((b) * 2 + (h)) * HTB)
#define PG8_SB(b, h) ((4 + (b) * 2 + (h)) * HTB)
#define PG8_STAGE(bufoff, gbase, voff) do { _Pragma("unroll") for (int _i = 0; _i < 2; ++_i) \
        __builtin_amdgcn_global_load_lds((const unsigned*)((const char*)(gbase) + (voff)[_i]), (PG8_LAS unsigned*)(lds + (bufoff) + ldsw + _i * 8192), 16, 0, 0); } while (0)
#define PG8_LDA(dst, b, h) do { _Pragma("unroll") for (int m = 0; m < 4; ++m) _Pragma("unroll") for (int k = 0; k < 2; ++k) dst[m][k] = *(const PG8_LAS bf16x8*)(lds + PG8_SA(b, h) + aoff + m * 2048 + k * 1024); } while (0)
#define PG8_LDB(dst, b, h) do { _Pragma("unroll") for (int n = 0; n < 2; ++n) _Pragma("unroll") for (int k = 0; k < 2; ++k) dst[n][k] = *(const PG8_LAS bf16x8*)(lds + PG8_SB(b, h) + boff + n * 2048 + k * 1024); } while (0)
#define PG8_MMA(ai, bj, At, Bt) do { __builtin_amdgcn_s_setprio(1); _Pragma("unroll") for (int m = 0; m < 4; ++m) _Pragma("unroll") for (int n = 0; n < 2; ++n) _Pragma("unroll") for (int k = 0; k < 2; ++k) \
        acc[ai][bj][m][n] = __builtin_amdgcn_mfma_f32_16x16x32_bf16(Bt[n][k], At[m][k], acc[ai][bj][m][n], 0, 0, 0); __builtin_amdgcn_s_setprio(0); } while (0)
#define PG8_WAIT_V(n) asm volatile("s_waitcnt vmcnt(" #n ")" ::: "memory")
#define PG8_WAIT_L(n) asm volatile("s_waitcnt lgkmcnt(" #n ")" ::: "memory")
#define PG8_BAR __builtin_amdgcn_s_barrier()
#define PG8_SCHED __builtin_amdgcn_sched_barrier(0)
    Unit cur, nxt; int ui = 0;
    if (!S.next(0, cur)) return;
    f32x4 acc[2][2][4][2];
#pragma unroll
    for (int a = 0; a < 2; ++a)
#pragma unroll
        for (int b = 0; b < 2; ++b)
#pragma unroll
            for (int m = 0; m < 4; ++m)
#pragma unroll
                for (int n = 0; n < 2; ++n) acc[a][b][m][n] = (f32x4){0.f, 0.f, 0.f, 0.f};
    bf16x8 At[4][2], B0[2][2], B1[2][2];
    const char* cA = (const char*)g.A + (size_t)cur.pm * tstep; const char* cB = (const char*)g.Bt + (size_t)cur.pn * tstep;
    S.a_ready(cur);
    if constexpr (SP2) {
        PG8_STAGE(PG8_SB(0, 0), cB, voffB); PG8_STAGE(PG8_SB(0, 1), cB + hstep, voffB); PG8_STAGE(PG8_SA(0, 0), cA, voffA); PG8_STAGE(PG8_SA(0, 1), cA + hstep, voffA);
        if (wr == 1) PG8_BAR;
        PG8_WAIT_V(2); PG8_BAR;
        PG8_STAGE(PG8_SB(1, 0), cB + kstep, voffB); PG8_STAGE(PG8_SA(1, 0), cA + kstep, voffA); PG8_STAGE(PG8_SB(1, 1), cB + hstep + kstep, voffB);
        PG8_WAIT_V(6); PG8_BAR;
    } else {
        PG8_STAGE(PG8_SB(0, 0), cB, voffB); PG8_STAGE(PG8_SA(0, 0), cA, voffA); PG8_STAGE(PG8_SB(0, 1), cB + hstep, voffB); PG8_STAGE(PG8_SA(0, 1), cA + hstep, voffA);
        if (wr == 1) PG8_BAR;
        PG8_WAIT_V(4); PG8_BAR;
        PG8_STAGE(PG8_SB(1, 0), cB + kstep, voffB); PG8_STAGE(PG8_SA(1, 0), cA + kstep, voffA); PG8_STAGE(PG8_SB(1, 1), cB + hstep + kstep, voffB);
        PG8_WAIT_V(6); PG8_BAR;
    }
    for (;;) {
        const bool has_next = S.next(ui + 1, nxt);
        const char* nA = has_next ? (const char*)g.A + (size_t)nxt.pm * tstep : cA; const char* nB = has_next ? (const char*)g.Bt + (size_t)nxt.pn * tstep : cB;
        for (int t = 0; t < nt; t += 2) {
            const bool last = (t == nt - 2);
            const char* a1 = cA + (size_t)(t + 1) * kstep;
            const char* a2 = last ? nA : cA + (size_t)(t + 2) * kstep; const char* b2 = last ? nB : cB + (size_t)(t + 2) * kstep;
            const char* a3 = a2 + kstep; const char* b3 = b2 + kstep;
            if (last && has_next) S.a_ready(nxt);
            if constexpr (SP2) {
            PG8_LDB(B0, 0, 0); PG8_LDB(B1, 0, 1); PG8_SCHED; PG8_LDA(At, 0, 0); PG8_STAGE(PG8_SA(1, 1), a1 + hstep, voffA);
            PG8_WAIT_V(8); PG8_WAIT_L(0); PG8_BAR; PG8_MMA(0, 0, At, B0); PG8_MMA(0, 1, At, B1); PG8_BAR; PG8_SCHED;
            PG8_LDA(At, 0, 1); PG8_STAGE(PG8_SB(0, 0), b2, voffB); PG8_STAGE(PG8_SB(0, 1), b2 + hstep, voffB); PG8_STAGE(PG8_SA(0, 0), a2, voffA);
            PG8_WAIT_V(8); PG8_WAIT_L(0); PG8_BAR; PG8_MMA(1, 0, At, B0); PG8_MMA(1, 1, At, B1); PG8_BAR; PG8_SCHED;
            PG8_LDB(B0, 1, 0); PG8_LDB(B1, 1, 1); PG8_SCHED; PG8_LDA(At, 1, 0); PG8_STAGE(PG8_SA(0, 1), a2 + hstep, voffA);
            PG8_WAIT_V(8); PG8_WAIT_L(0); PG8_BAR; PG8_MMA(0, 0, At, B0); PG8_MMA(0, 1, At, B1); PG8_BAR; PG8_SCHED;
            PG8_LDA(At, 1, 1); PG8_STAGE(PG8_SB(1, 0), b3, voffB); PG8_STAGE(PG8_SB(1, 1), b3 + hstep, voffB); PG8_STAGE(PG8_SA(1, 0), a3, voffA);
            PG8_WAIT_V(8); PG8_WAIT_L(0); PG8_BAR; PG8_MMA(1, 0, At, B0); PG8_MMA(1, 1, At, B1); PG8_BAR; PG8_SCHED;
            } else {
            PG8_LDB(B0, 0, 0); PG8_SCHED; PG8_LDA(At, 0, 0); PG8_STAGE(PG8_SA(1, 1), a1 + hstep, voffA);
            PG8_WAIT_L(8); PG8_BAR; PG8_WAIT_L(0); PG8_MMA(0, 0, At, B0); PG8_BAR; PG8_SCHED;
            PG8_LDB(B1, 0, 1); PG8_STAGE(PG8_SB(0, 0), b2, voffB);
            PG8_BAR; PG8_WAIT_L(0); PG8_MMA(0, 1, At, B1); PG8_BAR;
            PG8_LDA(At, 0, 1); PG8_STAGE(PG8_SA(0, 0), a2, voffA);
            PG8_BAR; PG8_WAIT_L(0); PG8_MMA(1, 0, At, B0); PG8_BAR; PG8_SCHED;
            PG8_STAGE(PG8_SB(0, 1), b2 + hstep, voffB);
            PG8_WAIT_V(6); PG8_BAR; PG8_MMA(1, 1, At, B1); PG8_BAR;
            PG8_LDB(B0, 1, 0); PG8_SCHED; PG8_LDA(At, 1, 0); PG8_STAGE(PG8_SA(0, 1), a2 + hstep, voffA);
            PG8_WAIT_L(8); PG8_BAR; PG8_WAIT_L(0); PG8_MMA(0, 0, At, B0); PG8_BAR; PG8_SCHED;
            PG8_LDB(B1, 1, 1); PG8_STAGE(PG8_SB(1, 0), b3, voffB);
            PG8_BAR; PG8_WAIT_L(0); PG8_MMA(0, 1, At, B1); PG8_BAR;
            PG8_LDA(At, 1, 1); PG8_STAGE(PG8_SA(1, 0), a3, voffA);
            PG8_BAR; PG8_WAIT_L(0); PG8_MMA(1, 0, At, B0); PG8_BAR; PG8_SCHED;
            PG8_STAGE(PG8_SB(1, 1), b3 + hstep, voffB);
            PG8_WAIT_V(6); PG8_BAR; PG8_MMA(1, 1, At, B1); PG8_BAR;
            }
        }
        if constexpr (ALIGN_EPI) { if (wr == 0) PG8_BAR; }
        if constexpr (!Epi::AFTER_DRAIN) { E(acc, cur, wr, wc, fr, fq); S.done(cur); }
        if (!has_next) break;
#pragma unroll
        for (int a = 0; a < 2; ++a)
#pragma unroll
            for (int b = 0; b < 2; ++b)
#pragma unroll
                for (int m = 0; m < 4; ++m)
#pragma unroll
                    for (int n = 0; n < 2; ++n) acc[a][b][m][n] = (f32x4){0.f, 0.f, 0.f, 0.f};
        cur = nxt; cA = nA; cB = nB; ++ui;
        if constexpr (ALIGN_EPI) { if (wr == 1) PG8_BAR; }
    }
    PG8_WAIT_V(0);
    if constexpr (!ALIGN_EPI) { if (wr == 0) PG8_BAR; }
    PG8_BAR;
    if constexpr (Epi::AFTER_DRAIN) { E.fused(acc, cur, wr, wc, fr, fq, lds, wid, lane); S.done(cur); }
#undef PG8_SA
#undef PG8_SB
#undef PG8_STAGE
#undef PG8_LDA
#undef PG8_LDB
#undef PG8_MMA
#undef PG8_WAIT_V
#undef PG8_WAIT_L
#undef PG8_BAR
#undef PG8_SCHED
}
}
#define LAS __attribute__((address_space(3)))
#define XB_TMO      128
#define XB_XCNT(j)  (256  + 64 * (j))
#define XB_XSUB(j)  (1280 + 64 * (j))
#define XB_XGEN(j)  (2304 + 64 * (j))
#define XB_TOP      3328
#define XB_TOPGEN   3392
#define XCD_BAR_WORDS 3456
#define XB_SPIN_CAP (1u << 18)

__device__ __forceinline__ unsigned xb_ld(unsigned* p)              { return __hip_atomic_load(p, __ATOMIC_RELAXED, __HIP_MEMORY_SCOPE_AGENT); }
__device__ __forceinline__ unsigned xb_add(unsigned* p, unsigned v) { return __hip_atomic_fetch_add(p, v, __ATOMIC_RELAXED, __HIP_MEMORY_SCOPE_AGENT); }
__device__ __forceinline__ unsigned xb_xcc_id() { return (unsigned)__builtin_amdgcn_s_getreg((3 << 11) | 20) & 0xFu; }
#define XB_SPIN(cond, bar) do { unsigned _sp = 0; while (cond) { __builtin_amdgcn_s_sleep(1); \
    if ((++_sp & 255u) == 0u) { if (xb_ld(&(bar)[XB_TMO])) break; if (_sp > XB_SPIN_CAP) { atomicAdd(&(bar)[XB_TMO], 1u); break; } } } } while (0)

struct XcdBarrier {
    unsigned* bar; unsigned x;
    volatile LAS unsigned* st;
};

__device__ __forceinline__ XcdBarrier xcd_barrier_post(unsigned* bar, volatile LAS unsigned* st) {
    XcdBarrier b; b.bar = bar; b.x = xb_xcc_id(); b.st = st;
    if (threadIdx.x == 0) (void)xb_add(&bar[XB_XCNT(b.x)], 1u);
    return b;
}
__device__ __forceinline__ void xcd_barrier_complete(unsigned* bar, unsigned x, unsigned& nloc, unsigned& nx) {
    const unsigned G = gridDim.x * gridDim.y * gridDim.z;
    unsigned sum, cnt, mine, sp = 0u;
    for (;;) {
        sum = 0u; cnt = 0u; mine = 0u;
#pragma unroll
        for (unsigned j = 0; j < 16; ++j) { const unsigned c = xb_ld(&bar[XB_XCNT(j)]); sum += c; cnt += (c > 0u) ? 1u : 0u; mine = (j == x) ? c : mine; }
        if (sum == G) break;
        __builtin_amdgcn_s_sleep(1);
        if ((++sp & 255u) == 0u) { if (xb_ld(&bar[XB_TMO])) break; if (sp > XB_SPIN_CAP) { atomicAdd(&bar[XB_TMO], 1u); break; } }
    }
    nloc = mine > 0u ? mine : 1u; nx = cnt > 0u ? cnt : 1u;
}

__device__ __forceinline__ void xcd_barrier(const XcdBarrier& b) {
    asm volatile("s_waitcnt vmcnt(0)" ::: "memory");
    __syncthreads();
    if (threadIdx.x == 0) {
        unsigned* bar = b.bar;
        __builtin_amdgcn_s_waitcnt(0);
        unsigned nloc = b.st[0], nx = b.st[1];
        if (nloc == 0u) { xcd_barrier_complete(bar, b.x, nloc, nx); b.st[0] = nloc; b.st[1] = nx; }
        const unsigned old = xb_add(&bar[XB_XSUB(b.x)], 1u);
        const unsigned gen = old / nloc;
        if (old + 1u == (gen + 1u) * nloc) {
            __builtin_amdgcn_fence(__ATOMIC_RELEASE, "agent");
            asm volatile("s_waitcnt vmcnt(0)" ::: "memory");
            const unsigned og = xb_add(&bar[XB_TOP], 1u);
            const unsigned tg = og / nx;
            if (og + 1u == (tg + 1u) * nx) xb_add(&bar[XB_TOPGEN], 1u);
            else XB_SPIN(xb_ld(&bar[XB_TOPGEN]) == tg, bar);
            __builtin_amdgcn_fence(__ATOMIC_ACQUIRE, "agent");
            xb_add(&bar[XB_XGEN(b.x)], 1u);
            asm volatile("s_waitcnt vmcnt(0)" ::: "memory");
        } else {
            XB_SPIN(xb_ld(&bar[XB_XGEN(b.x)]) == gen, bar);
            __builtin_amdgcn_fence(__ATOMIC_ACQUIRE, "agent");
            asm volatile("s_waitcnt vmcnt(0)" ::: "memory");
        }
    }
    __syncthreads();
}
using pg8::bf16_t; using pg8::bf16x8; using pg8::f32x4; using pg8::u32x4; using pg8::Unit;
typedef float f32x2_t __attribute__((ext_vector_type(2))); typedef __bf16 bf16x2_t __attribute__((ext_vector_type(2)));
__device__ __forceinline__ unsigned cvt_pk_bf16(float lo, float hi) { f32x2_t v = {lo, hi}; bf16x2_t b = __builtin_convertvector(v, bf16x2_t); return __builtin_bit_cast(unsigned, b); }
typedef unsigned u32x2 __attribute__((ext_vector_type(2)));
#define LAS __attribute__((address_space(3)))

constexpr int NTOK = 16384, DM = 1024, DFF = 2816, SEQ = 4096, NIN = 3584, NTHR = 512;
constexpr float EPS = 1e-6f;
constexpr size_t MiB = 1u << 20;
constexpr size_t WS_CTL = 0, WS_LBV = 64 * 1024, WS_DECAY = 1 * MiB, WS_PART0 = 2 * MiB, WS_PART1 = 3 * MiB, WS_PART2 = 4 * MiB;
constexpr size_t WS_W1GU = 6 * MiB, WS_W1D = 17 * MiB, WS_WIN = 22 * MiB + MiB / 2, WS_WOUT = 29 * MiB + MiB / 2, WS_W2GU = 31 * MiB + MiB / 2, WS_W2D = 42 * MiB + MiB / 2;
constexpr size_t WS_XB = 48 * MiB;
constexpr size_t WS_ACT = 80 * MiB;
constexpr size_t WS_QSB = 80 * MiB, WS_KSB = 96 * MiB, WS_VTSB = 112 * MiB, WS_QHG = 128 * MiB, WS_VTHG = 144 * MiB, WS_GHG = 160 * MiB;
constexpr size_t WS_LOGF = 176 * MiB;
constexpr size_t WS_LT = 208 * MiB;
constexpr size_t WS_XB2 = 176 * MiB;
constexpr size_t WS_END = 240 * MiB;

__device__ __forceinline__ float bf2f(unsigned short u) { return __uint_as_float((unsigned)u << 16); }
__device__ __forceinline__ bf16_t f2bf(float x) { return (bf16_t)(cvt_pk_bf16(x, 0.f) & 0xffffu); }
__device__ __forceinline__ float silu_f(float v) { return v * __builtin_amdgcn_rcpf(1.0f + __expf(-v)); }
__device__ __forceinline__ u32x4 pack8(const float* r) { u32x4 w; w.x = cvt_pk_bf16(r[0], r[1]); w.y = cvt_pk_bf16(r[2], r[3]); w.z = cvt_pk_bf16(r[4], r[5]); w.w = cvt_pk_bf16(r[6], r[7]); return w; }
__device__ __forceinline__ float row_rs(const float* part, int row, int fq) {
    const f32x4 p = *(const f32x4*)(part + (size_t)row * 16 + 4 * fq);
    float s = (p.x + p.y) + (p.z + p.w);
    s += __shfl_xor(s, 16); s += __shfl_xor(s, 32);
    return __builtin_amdgcn_rsqf(s * (1.0f / 1024.0f) + EPS);
}

struct EpiSwiglu {
    static constexpr bool PERM = true, AFTER_DRAIN = false;
    bf16_t* O; const float* part;
    __device__ __forceinline__ void operator()(const f32x4 (&acc)[2][2][4][2], const Unit& u, int wr, int wc, int fr, int fq) const {
        const int row0 = u.pm * 256 + wr * 64 + fr, col0 = u.pn * 128 + wc * 32 + 8 * fq;
#pragma unroll
        for (int ai = 0; ai < 2; ++ai)
#pragma unroll
            for (int m = 0; m < 4; ++m) {
                const int row = row0 + ai * 128 + m * 16;
                const float rs = row_rs(part, row, fq);
                float r[8];
#pragma unroll
                for (int n = 0; n < 2; ++n)
#pragma unroll
                    for (int j = 0; j < 4; ++j) { const float g = acc[ai][0][m][n][j] * rs, uu = acc[ai][1][m][n][j] * rs; r[n * 4 + j] = silu_f(g) * uu; }
                *(u32x4*)(O + (size_t)row * DFF + col0) = pack8(r);
            }
    }
};
struct EpiResid {
    static constexpr bool PERM = true, AFTER_DRAIN = false;
    const float* base; float* out; bf16_t* ob; float* part; float alpha;
    __device__ __forceinline__ void operator()(const f32x4 (&acc)[2][2][4][2], const Unit& u, int wr, int wc, int fr, int fq) const {
        const int row0 = u.pm * 256 + wr * 64 + fr, col0 = u.pn * 256 + wc * 32 + 8 * fq;
#pragma unroll
        for (int ai = 0; ai < 2; ++ai)
#pragma unroll
            for (int m = 0; m < 4; ++m) {
                const int row = row0 + ai * 128 + m * 16; float ss = 0.f;
#pragma unroll
                for (int bj = 0; bj < 2; ++bj) {
                    const size_t off = (size_t)row * DM + col0 + bj * 128;
                    const f32x4 b0 = *(const f32x4*)(base + off), b1 = *(const f32x4*)(base + off + 4);
                    const f32x4 v0 = b0 + acc[ai][bj][m][0] * alpha, v1 = b1 + acc[ai][bj][m][1] * alpha;
                    *(f32x4*)(out + off) = v0; *(f32x4*)(out + off + 4) = v1;
                    ss += (v0.x * v0.x + v0.y * v0.y) + (v0.z * v0.z + v0.w * v0.w) + (v1.x * v1.x + v1.y * v1.y) + (v1.z * v1.z + v1.w * v1.w);
                    if (ob) { const float r[8] = {v0.x, v0.y, v0.z, v0.w, v1.x, v1.y, v1.z, v1.w}; *(u32x4*)(ob + off) = pack8(r); }
                }
                if (part) { ss += __shfl_xor(ss, 16); ss += __shfl_xor(ss, 32); if (fq == 0) part[(size_t)row * 16 + u.pn * 4 + wc] = ss; }
            }
    }
};
struct EpiMix {
    static constexpr bool PERM = true, AFTER_DRAIN = false;
    const float* part; bf16_t *Qsb, *Ksb, *VTsb, *Qhg, *VThg, *Ghg; float* LogF; const float* lbv;
    __device__ __forceinline__ void operator()(const f32x4 (&acc)[2][2][4][2], const Unit& u, int wr, int wc, int fr, int fq) const {
        const int typ = u.pn >> 1;
        const int row0 = u.pm * 256 + wr * 64 + fr, cg0 = (u.pn & 1) * 256 + wc * 32 + 8 * fq;
#pragma unroll
        for (int ai = 0; ai < 2; ++ai)
#pragma unroll
            for (int m = 0; m < 4; ++m) {
                const int row = row0 + ai * 128 + m * 16;
                const float rs = row_rs(part, row, fq);
#pragma unroll
                for (int bj = 0; bj < 2; ++bj) {
                    const int cg = cg0 + bj * 128;
                    float r[8];
#pragma unroll
                    for (int n = 0; n < 2; ++n)
#pragma unroll
                        for (int j = 0; j < 4; ++j) r[n * 4 + j] = acc[ai][bj][m][n][j] * rs;
                    const size_t off = (size_t)row * 512 + cg;
                    if (typ == 0) {
#pragma unroll
                        for (int j = 0; j < 8; ++j) r[j] *= 0.125f * 1.4426950408889634f;
                        *(u32x4*)(Qsb + off) = pack8(r);
                    } else if (typ == 1) {
                        const int hh = cg >> 6, d0 = cg & 63, tt = row & (SEQ - 1);
                        const size_t kidx = ((((size_t)((row >> 12) * 8 + hh) * 64 + (tt >> 6)) * 4 + ((tt & 63) >> 4)) * 2 + (d0 >> 5)) * 64 + (tt & 15) + 16 * ((d0 & 31) >> 3);
                        *(u32x4*)(Ksb + kidx * 8) = pack8(r);
                    } else if (typ == 2) {
                        const int hh = cg >> 6, d0 = cg & 63, tt = row & (SEQ - 1), kk = tt & 31;
                        bf16_t* dst = VTsb + (((((size_t)((row >> 12) * 8 + hh) * 64 + (tt >> 6)) * 4 + (d0 >> 4)) * 2 + ((tt & 63) >> 5)) * 64 + (d0 & 15) + 16 * ((kk & 15) >> 2)) * 8 + (kk & 3) + 4 * (kk >> 4);
#pragma unroll
                        for (int j = 0; j < 8; ++j) dst[j * 8] = f2bf(r[j]);
                    } else if (typ == 5) {
                        bf16_t* dst = VThg + ((size_t)(row >> 12) * 512 + cg) * SEQ + (row & (SEQ - 1));
#pragma unroll
                        for (int j = 0; j < 8; ++j) dst[(size_t)j * SEQ] = f2bf(r[j]);
                    } else if (typ == 3 || typ == 6) {
#pragma unroll
                        for (int j = 0; j < 8; ++j) r[j] = silu_f(r[j]);
                        *(u32x4*)((typ == 3 ? Qhg : Ghg) + off) = pack8(r);
                    } else {
                        const f32x4 l0 = *(const f32x4*)(lbv + cg), l1 = *(const f32x4*)(lbv + cg + 4);
                        const float lb[8] = {l0.x, l0.y, l0.z, l0.w, l1.x, l1.y, l1.z, l1.w};
#pragma unroll
                        for (int j = 0; j < 8; ++j) { const float sg = __builtin_amdgcn_rcpf(1.0f + __expf(-r[j])); r[j] = __logf(lb[j] + (1.0f - lb[j]) * sg); }
                        *(f32x4*)(LogF + off) = (f32x4){r[0], r[1], r[2], r[3]}; *(f32x4*)(LogF + off + 4) = (f32x4){r[4], r[5], r[6], r[7]};
                    }
                }
            }
    }
};

__device__ __forceinline__ float wave_sum(float v) {
#pragma unroll
    for (int o = 1; o < 64; o <<= 1) v += __shfl_xor(v, o);
    return v;
}
__device__ __forceinline__ void p0_transpose_item(const float* W, int K, int N, bf16_t* WT, const float* gain, int mode, int row_off, LAS float* scr, int item, int lane) {
    const int nblk = N / 32, kb = item / nblk, nb = item % nblk, k0 = 64 * kb, n0 = 32 * nb;
#pragma unroll 8
    for (int i = 0; i < 32; ++i) { const int kk = 2 * i + (lane >> 5); const float gsc = gain ? gain[k0 + kk] : 1.0f; scr[kk * 33 + (lane & 31)] = W[(size_t)(k0 + kk) * N + n0 + (lane & 31)] * gsc; }
    asm volatile("s_waitcnt lgkmcnt(0)" ::: "memory");
    const int c = lane & 7;
    const int rb = mode ? ((n0 >> 7) * 256 + (n0 & 127) + row_off) : n0;
#pragma unroll
    for (int j = 0; j < 4; ++j) { const int n = (lane >> 3) + 8 * j; const LAS float* s = scr + (8 * c) * 33 + n;
        u32x4 o; o.x = cvt_pk_bf16(s[0 * 33], s[1 * 33]); o.y = cvt_pk_bf16(s[2 * 33], s[3 * 33]); o.z = cvt_pk_bf16(s[4 * 33], s[5 * 33]); o.w = cvt_pk_bf16(s[6 * 33], s[7 * 33]);
        *(u32x4*)(WT + (size_t)(rb + n) * K + k0 + 8 * c) = o; }
    asm volatile("s_waitcnt lgkmcnt(0)" ::: "memory");
}

struct Args { const float* in[16]; float* out; unsigned char* ws; int ph_lo, ph_hi; };

struct AttnState { f32x4 o[4]; float carry; };
template <bool DIAG>
__device__ __forceinline__ void attn_tile(AttnState& st, const bf16x8 (&kf)[8], const bf16x8 (&qf)[2], const u32x2 (&vlo)[4][2], const u32x2 (&vhi)[4][2], int kt0, int t, int fq) {
    f32x4 z[4];
#pragma unroll
    for (int g = 0; g < 4; ++g) {
        z[g] = __builtin_amdgcn_mfma_f32_16x16x32_bf16(kf[2 * g], qf[0], (f32x4){0.f, 0.f, 0.f, 0.f}, 0, 0, 0);
        z[g] = __builtin_amdgcn_mfma_f32_16x16x32_bf16(kf[2 * g + 1], qf[1], z[g], 0, 0, 0);
    }
    float lr[4][4], lbt[4][4];
#pragma unroll
    for (int g = 0; g < 4; ++g)
#pragma unroll
        for (int i = 0; i < 4; ++i) {
            const float zz = z[g][i];
            const float sp = fmaxf(zz, 0.f) + __builtin_amdgcn_logf(1.0f + __builtin_amdgcn_exp2f(-fabsf(zz)));
            lbt[g][i] = zz - sp;
            if (DIAG) { const bool act = (kt0 + 16 * g + 4 * fq + i) < t; lr[g][i] = act ? -sp : 0.f; if (!act) lbt[g][i] = -INFINITY; }
            else lr[g][i] = -sp;
        }
    float e[4][4], T[4], X[4];
#pragma unroll
    for (int g = 0; g < 4; ++g) {
        e[g][3] = 0.f; e[g][2] = lr[g][3]; e[g][1] = e[g][2] + lr[g][2]; e[g][0] = e[g][1] + lr[g][1];
        const float sg = e[g][0] + lr[g][0];
        const float a1 = __shfl_xor(sg, 16), a2 = __shfl_xor(sg, 32), a3 = __shfl_xor(sg, 48);
        T[g] = (sg + a1) + (a2 + a3);
        X[g] = ((fq ^ 1) > fq ? a1 : 0.f) + ((fq ^ 2) > fq ? a2 : 0.f) + ((fq ^ 3) > fq ? a3 : 0.f);
    }
    float G[4]; G[3] = st.carry + X[3]; G[2] = st.carry + T[3]; G[1] = G[2] + T[2]; G[0] = G[1] + T[1];
    st.carry = G[0] + T[0];
    G[2] += X[2]; G[1] += X[1]; G[0] += X[0];
    float w[4][4];
#pragma unroll
    for (int g = 0; g < 4; ++g)
#pragma unroll
        for (int i = 0; i < 4; ++i) w[g][i] = __builtin_amdgcn_exp2f(lbt[g][i] + (G[g] + e[g][i]));
#pragma unroll
    for (int s = 0; s < 2; ++s) {
        u32x4 wb; wb.x = cvt_pk_bf16(w[2 * s][0], w[2 * s][1]); wb.y = cvt_pk_bf16(w[2 * s][2], w[2 * s][3]); wb.z = cvt_pk_bf16(w[2 * s + 1][0], w[2 * s + 1][1]); wb.w = cvt_pk_bf16(w[2 * s + 1][2], w[2 * s + 1][3]);
        const bf16x8 wf = __builtin_bit_cast(bf16x8, wb);
#pragma unroll
        for (int db = 0; db < 4; ++db) {
            u32x4 va; va.x = vlo[db][s].x; va.y = vlo[db][s].y; va.z = vhi[db][s].x; va.w = vhi[db][s].y;
            st.o[db] = __builtin_amdgcn_mfma_f32_16x16x32_bf16(__builtin_bit_cast(bf16x8, va), wf, st.o[db], 0, 0, 0);
        }
    }
}
__device__ __forceinline__ void attn_wave_item(int item, const bf16_t* Qsb, const bf16_t* Ksb, const bf16_t* VTsb, const float* gain, bf16_t* mixed, int lane) {
    const int bh = item >> 7, qb = item & 127, b = bh >> 3, h = bh & 7, q0 = qb * 32;
    const int fr = lane & 15, fq = lane >> 4;
    bf16x8 qf[2][2]; AttnState st[2];
#pragma unroll
    for (int u = 0; u < 2; ++u) {
        const bf16_t* Qrow = Qsb + ((size_t)b * SEQ + q0 + 16 * u + fr) * 512 + h * 64;
        qf[u][0] = *(const bf16x8*)(Qrow + 8 * fq); qf[u][1] = *(const bf16x8*)(Qrow + 32 + 8 * fq);
#pragma unroll
        for (int i = 0; i < 4; ++i) st[u].o[i] = (f32x4){0.f, 0.f, 0.f, 0.f};
        st[u].carry = 0.f;
    }
    const bf16_t* Kbase = Ksb + (size_t)bh * 64 * 4096 + lane * 8;
    const bf16_t* Vbase = VTsb + (size_t)bh * 64 * 4096 + lane * 8;
    int kt0 = q0 & ~63;
    bf16x8 kf[8]; u32x2 vlo[4][2], vhi[4][2];
#define ATT_LOADK(dst, kt) do { const bf16_t* kp = Kbase + (size_t)((kt) >> 6) * 4096; _Pragma("unroll") for (int i = 0; i < 8; ++i) dst[i] = *(const bf16x8*)(kp + i * 512); } while (0)
#define ATT_LOADV(kt) do { const bf16_t* vp = Vbase + (size_t)((kt) >> 6) * 4096; _Pragma("unroll") for (int db = 0; db < 4; ++db) _Pragma("unroll") for (int s = 0; s < 2; ++s) { const u32x4 vv = *(const u32x4*)(vp + (db * 2 + s) * 512); vlo[db][s].x = vv.x; vlo[db][s].y = vv.y; vhi[db][s].x = vv.z; vhi[db][s].y = vv.w; } } while (0)
    ATT_LOADK(kf, kt0); ATT_LOADV(kt0);
    attn_tile<true>(st[0], kf, qf[0], vlo, vhi, kt0, q0 + fr, fq);
    attn_tile<true>(st[1], kf, qf[1], vlo, vhi, kt0, q0 + 16 + fr, fq);
    while (kt0 >= 64 && __any(fmaxf(st[0].carry, st[1].carry) >= -150.0f)) {
        kt0 -= 64;
        ATT_LOADK(kf, kt0); ATT_LOADV(kt0);
        attn_tile<false>(st[0], kf, qf[0], vlo, vhi, kt0, 0, fq);
        attn_tile<false>(st[1], kf, qf[1], vlo, vhi, kt0, 0, fq);
    }
#undef ATT_LOADK
#undef ATT_LOADV
#pragma unroll
    for (int u = 0; u < 2; ++u) {
        float ss = 0.f;
#pragma unroll
        for (int db = 0; db < 4; ++db) ss += (st[u].o[db].x * st[u].o[db].x + st[u].o[db].y * st[u].o[db].y) + (st[u].o[db].z * st[u].o[db].z + st[u].o[db].w * st[u].o[db].w);
        ss += __shfl_xor(ss, 16); ss += __shfl_xor(ss, 32);
        const float rn = __builtin_amdgcn_rsqf(ss * (1.0f / 64.0f) + EPS);
        bf16_t* op = mixed + ((size_t)b * SEQ + q0 + 16 * u + fr) * DM + h * 64 + 4 * fq;
#pragma unroll
        for (int db = 0; db < 4; ++db) {
            const f32x4 gn = *(const f32x4*)(gain + h * 64 + 16 * db + 4 * fq);
            u32x2 stv; stv.x = cvt_pk_bf16(st[u].o[db].x * rn * gn.x, st[u].o[db].y * rn * gn.y); stv.y = cvt_pk_bf16(st[u].o[db].z * rn * gn.z, st[u].o[db].w * rn * gn.w);
#ifdef DBG_SKIP_SB
            stv.x = 0u; stv.y = 0u;
#endif
            *(u32x2*)(op + 16 * db) = stv;
        }
    }
}

constexpr int QE_P = 136, KS_P = 72;
__device__ __forceinline__ void hgrn_pass_a(LAS unsigned char* lds, int it, float* LogF, bf16_t* Qhg, const bf16_t* VThg, float* decay, bf16_t* LT) {
    const int tid = threadIdx.x, lane = tid & 63, w = __builtin_amdgcn_readfirstlane(tid >> 6), fr = lane & 15, fq = lane >> 4;
    const int bh = it >> 6, c = it & 63, b = bh >> 2, h = bh & 3;
    const size_t tok0 = (size_t)b * SEQ + 64 * c;
    LAS float* tot = (LAS float*)lds;
    LAS bf16_t* QE = (LAS bf16_t*)(lds + 2048);
    LAS bf16_t* KI = (LAS bf16_t*)(lds + 2048 + 64 * QE_P * 2);
    LAS bf16_t* KS = (LAS bf16_t*)(lds + 2048 + 2 * 64 * QE_P * 2);
    {
        const int d = tid & 127, part = tid >> 7;
        float lf[16], cs[16]; float run = 0.f;
        const float* lp = LogF + (tok0 + 16 * part) * 512 + h * 128 + d;
        bf16_t* qp = Qhg + (tok0 + 16 * part) * 512 + h * 128 + d;
        float qv[16];
#pragma unroll
        for (int i = 0; i < 16; ++i) { lf[i] = lp[(size_t)i * 512]; qv[i] = bf2f(qp[(size_t)i * 512]); }
#pragma unroll
        for (int i = 0; i < 16; ++i) { run += lf[i]; cs[i] = run; }
        tot[part * 128 + d] = run;
        __syncthreads();
        const float t0 = tot[d], t1 = tot[128 + d], t2 = tot[256 + d], t3 = tot[384 + d];
        const float off = (part > 0 ? t0 : 0.f) + (part > 1 ? t1 : 0.f) + (part > 2 ? t2 : 0.f);
        const float bl = (t0 + t1) + (t2 + t3);
#pragma unroll
        for (int i = 0; i < 16; ++i) {
            const int s = 16 * part + i; const float bb = off + cs[i];
            const float kk = 1.0f - __expf(lf[i]);
            const bf16_t qb = f2bf(qv[i] * __expf(bb));
            QE[s * QE_P + d] = qb; qp[(size_t)i * 512] = qb;
            KI[s * QE_P + d] = f2bf(kk * __expf(-bb));
            KS[d * KS_P + s] = f2bf(kk * __expf(bl - bb));
        }
        if (part == 0) decay[(size_t)it * 128 + d] = __expf(bl);
    }
    __syncthreads();
    {
        const int tblk = w & 3, vhalf = w >> 2;
        bf16x8 qf[4];
#pragma unroll
        for (int ks = 0; ks < 4; ++ks) qf[ks] = *(const LAS bf16x8*)(QE + (16 * tblk + fr) * QE_P + 32 * ks + 8 * fq);
        f32x4 sc[4];
#pragma unroll
        for (int sb = 0; sb < 4; ++sb) {
            sc[sb] = (f32x4){0.f, 0.f, 0.f, 0.f};
            if (sb <= tblk) {
#pragma unroll
                for (int ks = 0; ks < 4; ++ks) { const bf16x8 af = *(const LAS bf16x8*)(KI + (16 * sb + fr) * QE_P + 32 * ks + 8 * fq); sc[sb] = __builtin_amdgcn_mfma_f32_16x16x32_bf16(af, qf[ks], sc[sb], 0, 0, 0); }
            }
#pragma unroll
            for (int i = 0; i < 4; ++i) if (sb == tblk && (4 * fq + i) > fr) sc[sb][i] = 0.f;
        }
        bf16x8 pf[2];
#pragma unroll
        for (int p = 0; p < 2; ++p) { u32x4 wb; wb.x = cvt_pk_bf16(sc[2 * p][0], sc[2 * p][1]); wb.y = cvt_pk_bf16(sc[2 * p][2], sc[2 * p][3]); wb.z = cvt_pk_bf16(sc[2 * p + 1][0], sc[2 * p + 1][1]); wb.w = cvt_pk_bf16(sc[2 * p + 1][2], sc[2 * p + 1][3]); pf[p] = __builtin_bit_cast(bf16x8, wb); }
#pragma unroll
        for (int vb = 0; vb < 4; ++vb) {
            const int v = 64 * vhalf + 16 * vb + fr;
            const bf16_t* vp = VThg + ((size_t)bh * 128 + v) * SEQ + 64 * c + 4 * fq;
            f32x4 acc = (f32x4){0.f, 0.f, 0.f, 0.f};
#pragma unroll
            for (int p = 0; p < 2; ++p) if (2 * p <= tblk) {
                const u32x2 lo = *(const u32x2*)(vp + 32 * p), hi = *(const u32x2*)(vp + 32 * p + 16);
                u32x4 va; va.x = lo.x; va.y = lo.y; va.z = hi.x; va.w = hi.y;
                acc = __builtin_amdgcn_mfma_f32_16x16x32_bf16(__builtin_bit_cast(bf16x8, va), pf[p], acc, 0, 0, 0);
            }
            *(f32x4*)(LogF + (tok0 + 16 * tblk + fr) * 512 + h * 128 + 64 * vhalf + 16 * vb + 4 * fq) = acc;
        }
    }
    {
        bf16x8 af[2];
#pragma unroll
        for (int ks = 0; ks < 2; ++ks) af[ks] = *(const LAS bf16x8*)(KS + (16 * w + fr) * KS_P + 32 * ks + 8 * fq);
#pragma unroll
        for (int vb = 0; vb < 8; ++vb) {
            const int v = 16 * vb + fr;
            const bf16_t* vp = VThg + ((size_t)bh * 128 + v) * SEQ + 64 * c + 8 * fq;
            f32x4 acc = (f32x4){0.f, 0.f, 0.f, 0.f};
#pragma unroll
            for (int ks = 0; ks < 2; ++ks) { const bf16x8 bfr = *(const bf16x8*)(vp + 32 * ks); acc = __builtin_amdgcn_mfma_f32_16x16x32_bf16(af[ks], bfr, acc, 0, 0, 0); }
            u32x2 st; st.x = cvt_pk_bf16(acc.x, acc.y); st.y = cvt_pk_bf16(acc.z, acc.w);
            *(u32x2*)(LT + ((size_t)it * 128 + v) * 128 + 16 * w + 4 * fq) = st;
        }
    }
    __syncthreads();
}

__device__ __forceinline__ void hgrn_pass_c(int item, const float* OI, const bf16_t* Qe, const bf16_t* ST, const bf16_t* Ghg, const float* gain, bf16_t* mixed, int lane) {
    const int bh = item >> 8, c = (item >> 2) & 63, tblk = item & 3, b = bh >> 2, h = bh & 3;
    const int fr = lane & 15, fq = lane >> 4;
    const size_t tok = (size_t)b * SEQ + 64 * c + 16 * tblk + fr;
    bf16x8 qf[4];
#pragma unroll
    for (int ks = 0; ks < 4; ++ks) qf[ks] = *(const bf16x8*)(Qe + tok * 512 + h * 128 + 32 * ks + 8 * fq);
    f32x4 acc[8];
#pragma unroll
    for (int vb = 0; vb < 8; ++vb) acc[vb] = *(const f32x4*)(OI + tok * 512 + h * 128 + 16 * vb + 4 * fq);
    if (c > 0) {
        const bf16_t* sp = ST + ((size_t)(bh * 64 + c - 1) * 128 + fr) * 128 + 8 * fq;
#pragma unroll
        for (int vb = 0; vb < 8; ++vb)
#pragma unroll
            for (int ks = 0; ks < 4; ++ks) { const bf16x8 af = *(const bf16x8*)(sp + (size_t)(16 * vb) * 128 + 32 * ks); acc[vb] = __builtin_amdgcn_mfma_f32_16x16x32_bf16(af, qf[ks], acc[vb], 0, 0, 0); }
    }
    float ss = 0.f;
#pragma unroll
    for (int vb = 0; vb < 8; ++vb) ss += (acc[vb].x * acc[vb].x + acc[vb].y * acc[vb].y) + (acc[vb].z * acc[vb].z + acc[vb].w * acc[vb].w);
    ss += __shfl_xor(ss, 16); ss += __shfl_xor(ss, 32);
    const float rn = __builtin_amdgcn_rsqf(ss * (1.0f / 128.0f) + EPS);
#pragma unroll
    for (int vb = 0; vb < 8; ++vb) {
        const int col = h * 128 + 16 * vb + 4 * fq;
        const f32x4 gn = *(const f32x4*)(gain + col);
        const u32x2 gg = *(const u32x2*)(Ghg + tok * 512 + col);
        const float g0 = __uint_as_float(gg.x << 16), g1 = __uint_as_float(gg.x & 0xffff0000u), g2 = __uint_as_float(gg.y << 16), g3 = __uint_as_float(gg.y & 0xffff0000u);
        u32x2 st; st.x = cvt_pk_bf16(acc[vb].x * rn * gn.x * g0, acc[vb].y * rn * gn.y * g1); st.y = cvt_pk_bf16(acc[vb].z * rn * gn.z * g2, acc[vb].w * rn * gn.w * g3);
#ifdef DBG_SKIP_HG
        st.x = 0u; st.y = 0u;
#endif
        *(u32x2*)(mixed + tok * DM + 512 + col) = st;
    }
}

constexpr int LDS_BYTES = 131072 + 1024;
constexpr int CW_BAR = 1024;
#define GRID_SYNC0() do { asm volatile("s_waitcnt vmcnt(0) lgkmcnt(0)" ::: "memory"); grid.sync(); \
    if (wave == 0) { __builtin_amdgcn_fence(__ATOMIC_ACQUIRE, "agent"); asm volatile("s_waitcnt vmcnt(0)" ::: "memory"); } __syncthreads(); } while (0)
#ifndef REP_P1
#define REP_P1 1
#endif
#ifndef REP_P2
#define REP_P2 1
#endif
#ifndef REP_P3
#define REP_P3 1
#endif
#ifndef REP_ATT
#define REP_ATT 1
#endif
#ifndef REP_P4C
#define REP_P4C 1
#endif
#ifndef REP_P0
#define REP_P0 1
#endif
#define PH(k) if (a.ph_lo <= (k) && (k) < a.ph_hi)
#define SEAM(k) do { if (a.ph_lo <= (k) && (k) + 1 < a.ph_hi) { if ((k) == 0) { GRID_SYNC0(); xbar = xcd_barrier_post(ctl + CW_BAR, (volatile LAS unsigned*)(lds + 131072 + 64)); } else xcd_barrier(xbar); } } while (0)
#ifndef DBG_NPH
#define DBG_NPH 11
#endif
#ifndef N_LAUNCHES
#define N_LAUNCHES 1
#endif
#define GEMM_PHASE(EpiT, Aptr, Bptr, Nn, Kk, Eobj) do { pg8::Gemm g_{(const bf16_t*)(Aptr), (const bf16_t*)(Bptr), NTOK, (Nn), (Kk)}; pg8::StaticOrder S_; S_.init(NTOK, (Nn), (int)gridDim.x, (int)blockIdx.x); \
    pg8::gemm_phase<EpiT, pg8::StaticOrder, true, true>(lds, g_, S_, (Eobj)); } while (0)

__global__ void __launch_bounds__(NTHR) fwd_kernel(Args a) {
    extern __shared__ __attribute__((aligned(16))) unsigned char lds_raw[];
    LAS unsigned char* lds = (LAS unsigned char*)lds_raw;
    cg::grid_group grid = cg::this_grid();
    const int tid = threadIdx.x, lane = tid & 63, wave = __builtin_amdgcn_readfirstlane(tid >> 6);
    const int gw = blockIdx.x * 8 + wave, NGW = gridDim.x * 8;
    unsigned char* ws = a.ws;
    unsigned* ctl = (unsigned*)(ws + WS_CTL);
    float* lbv = (float*)(ws + WS_LBV); float* decay = (float*)(ws + WS_DECAY);
    float* part0 = (float*)(ws + WS_PART0); float* part1 = (float*)(ws + WS_PART1); float* part2 = (float*)(ws + WS_PART2);
    bf16_t* W1gu = (bf16_t*)(ws + WS_W1GU); bf16_t* W1d = (bf16_t*)(ws + WS_W1D); bf16_t* Win = (bf16_t*)(ws + WS_WIN); bf16_t* Wout = (bf16_t*)(ws + WS_WOUT);
    bf16_t* W2gu = (bf16_t*)(ws + WS_W2GU); bf16_t* W2d = (bf16_t*)(ws + WS_W2D);
    bf16_t* XB = (bf16_t*)(ws + WS_XB); bf16_t* ACT = (bf16_t*)(ws + WS_ACT); bf16_t* XB2 = (bf16_t*)(ws + WS_XB2);
    bf16_t* Qsb = (bf16_t*)(ws + WS_QSB); bf16_t* Ksb = (bf16_t*)(ws + WS_KSB); bf16_t* VTsb = (bf16_t*)(ws + WS_VTSB);
    bf16_t* Qhg = (bf16_t*)(ws + WS_QHG); bf16_t* VThg = (bf16_t*)(ws + WS_VTHG); bf16_t* Ghg = (bf16_t*)(ws + WS_GHG);
    float* LogF = (float*)(ws + WS_LOGF); bf16_t* LT = (bf16_t*)(ws + WS_LT);
    bf16_t* MIXED = XB;
    const float* x = a.in[0]; float* out = a.out;
    if (tid < 2) ((LAS unsigned*)(lds + 131072 + 64))[tid] = 0u;
    __syncthreads();
    XcdBarrier xbar; xbar.bar = ctl + CW_BAR; xbar.x = 0; xbar.st = nullptr;

    PH(0) { for (int rep0 = 0; rep0 < REP_P0; ++rep0) {
    {
        if (blockIdx.x == 0) { if (tid < 4) ctl[16 * tid] = 0u; for (int i = tid; i < XCD_BAR_WORDS; i += NTHR) ctl[CW_BAR + i] = 0u; }
        if (blockIdx.x == 0) { const float* lg = a.in[8]; for (int c = tid; c < 512; c += NTHR) lbv[c] = 1.0f / (1.0f + __expf(lg[512 + c] - lg[c])); }
        LAS float* scr = (LAS float*)(lds + wave * 16384);
        constexpr int I_GU = 16 * 88, I_D = 44 * 32, I_IN = 16 * 112, I_OUT = 16 * 32;
        constexpr int NITEMS = 4 * I_GU + 2 * I_D + I_IN + I_OUT;
        for (int it = gw; it < NITEMS; it += NGW) {
            int r = it;
            if (r < I_GU) { p0_transpose_item(a.in[2], DM, DFF, W1gu, a.in[1], 1, 0, scr, r, lane); continue; } r -= I_GU;
            if (r < I_GU) { p0_transpose_item(a.in[3], DM, DFF, W1gu, a.in[1], 1, 128, scr, r, lane); continue; } r -= I_GU;
            if (r < I_D) { p0_transpose_item(a.in[4], DFF, DM, W1d, nullptr, 0, 0, scr, r, lane); continue; } r -= I_D;
            if (r < I_IN) { p0_transpose_item(a.in[6], DM, NIN, Win, a.in[5], 0, 0, scr, r, lane); continue; } r -= I_IN;
            if (r < I_OUT) { p0_transpose_item(a.in[10], DM, DM, Wout, nullptr, 0, 0, scr, r, lane); continue; } r -= I_OUT;
            if (r < I_GU) { p0_transpose_item(a.in[12], DM, DFF, W2gu, a.in[11], 1, 0, scr, r, lane); continue; } r -= I_GU;
            if (r < I_GU) { p0_transpose_item(a.in[13], DM, DFF, W2gu, a.in[11], 1, 128, scr, r, lane); continue; } r -= I_GU;
            p0_transpose_item(a.in[14], DFF, DM, W2d, nullptr, 0, 0, scr, r, lane);
        }
        for (int m = gw; m < NTOK; m += NGW) {
            const f32x4* xr = (const f32x4*)(x + (size_t)m * DM) + lane; f32x4 v[4]; float s = 0.f;
#pragma unroll
            for (int j = 0; j < 4; ++j) { v[j] = xr[64 * j]; s += (v[j].x * v[j].x + v[j].y * v[j].y) + (v[j].z * v[j].z + v[j].w * v[j].w); }
            s = wave_sum(s);
            u32x2* o8 = (u32x2*)(XB + (size_t)m * DM) + lane;
#pragma unroll
            for (int j = 0; j < 4; ++j) { u32x2 st; st.x = cvt_pk_bf16(v[j].x, v[j].y); st.y = cvt_pk_bf16(v[j].z, v[j].w); o8[64 * j] = st; }
            if (lane < 16) part0[(size_t)m * 16 + lane] = (lane == 0) ? s : 0.f;
        }
    }
    } } SEAM(0); PH(1) {
    for (int rep = 0; rep < REP_P1; ++rep) { EpiSwiglu E{ACT, part0}; GEMM_PHASE(EpiSwiglu, XB, W1gu, 2 * DFF, DM, E); }
    } SEAM(1); PH(2) {
    for (int rep = 0; rep < REP_P2; ++rep) { EpiResid E{x, out, XB, part1, 0.5f}; GEMM_PHASE(EpiResid, ACT, W1d, DM, DFF, E); }
    } SEAM(2); PH(3) {
    for (int rep = 0; rep < REP_P3; ++rep) { EpiMix E{part1, Qsb, Ksb, VTsb, Qhg, VThg, Ghg, LogF, lbv}; GEMM_PHASE(EpiMix, XB, Win, NIN, DM, E); }
    } SEAM(3); PH(4) {
    for (int it = blockIdx.x; it < 1024; it += gridDim.x) hgrn_pass_a(lds, it, LogF, Qhg, VThg, decay, LT);
    } SEAM(4); PH(5) {
    if (wave < 4) {
        for (int gid = blockIdx.x * 256 + tid; gid < 65536; gid += gridDim.x * 256) {
            const int bh = gid >> 12, v = (gid >> 5) & 127, d4 = (gid & 31) * 4;
            f32x4 S = (f32x4){0.f, 0.f, 0.f, 0.f};
            for (int c0 = 0; c0 < 64; c0 += 16) {
                f32x4 dec[16]; u32x2 l[16];
#pragma unroll
                for (int j = 0; j < 16; ++j) { dec[j] = *(const f32x4*)(decay + (size_t)(bh * 64 + c0 + j) * 128 + d4); l[j] = *(const u32x2*)(LT + ((size_t)(bh * 64 + c0 + j) * 128 + v) * 128 + d4); }
#pragma unroll
                for (int j = 0; j < 16; ++j) {
                    S.x = dec[j].x * S.x + __uint_as_float(l[j].x << 16); S.y = dec[j].y * S.y + __uint_as_float(l[j].x & 0xffff0000u);
                    S.z = dec[j].z * S.z + __uint_as_float(l[j].y << 16); S.w = dec[j].w * S.w + __uint_as_float(l[j].y & 0xffff0000u);
                    u32x2 st; st.x = cvt_pk_bf16(S.x, S.y); st.y = cvt_pk_bf16(S.z, S.w);
                    *(u32x2*)(LT + ((size_t)(bh * 64 + c0 + j) * 128 + v) * 128 + d4) = st;
                }
            }
        }
    }
    for (int rep = 0; rep < REP_ATT; ++rep)
    for (int item = gw; item < 4096; item += NGW) attn_wave_item(item, Qsb, Ksb, VTsb, a.in[7], MIXED, lane);
    } SEAM(5); PH(6) {
    for (int rep = 0; rep < REP_P4C; ++rep)
    for (int item = gw; item < 4096; item += NGW) hgrn_pass_c(item, LogF, Qhg, LT, Ghg, a.in[9], MIXED, lane);
    } SEAM(6); PH(7) {
    { EpiResid E{out, out, XB2, part2, 1.0f}; GEMM_PHASE(EpiResid, MIXED, Wout, DM, DM, E); }
    } SEAM(7); PH(8) {
    { EpiSwiglu E{ACT, part2}; GEMM_PHASE(EpiSwiglu, XB2, W2gu, 2 * DFF, DM, E); }
    } SEAM(8); PH(9) {
    { EpiResid E{out, out, nullptr, nullptr, 0.5f}; GEMM_PHASE(EpiResid, ACT, W2d, DM, DFF, E); }
    } SEAM(9); PH(10) {
    {
        const float* fg = a.in[15];
        for (int m = gw; m < NTOK; m += NGW) {
            f32x4* xr = (f32x4*)(out + (size_t)m * DM) + lane; f32x4 v[4]; float s = 0.f;
#pragma unroll
            for (int j = 0; j < 4; ++j) { v[j] = xr[64 * j]; s += (v[j].x * v[j].x + v[j].y * v[j].y) + (v[j].z * v[j].z + v[j].w * v[j].w); }
            s = wave_sum(s);
            const float rn = __builtin_amdgcn_rsqf(s * (1.0f / 1024.0f) + EPS);
#pragma unroll
            for (int j = 0; j < 4; ++j) { const f32x4 g = *((const f32x4*)fg + lane + 64 * j); xr[64 * j] = v[j] * rn * g; }
        }
    }
    }
}

extern "C" void kernel_launch(void* const* d_in, const int* in_sizes, int n_in, void* d_out, int out_size, void* d_ws, size_t ws_size, hipStream_t stream) {
    static int grid = 0;
    if (grid == 0) {
        if (n_in != 16 || out_size != NTOK * DM || ws_size < WS_END) { fprintf(stderr, "kernel_launch: unexpected problem shape (n_in %d, out %d, ws %zu)\n", n_in, out_size, ws_size); grid = -1; return; }
        int dev = 0, cus = 0, per_cu = 0;
        hipGetDevice(&dev); hipDeviceGetAttribute(&cus, hipDeviceAttributeMultiprocessorCount, dev);
        hipFuncSetAttribute((const void*)fwd_kernel, hipFuncAttributeMaxDynamicSharedMemorySize, LDS_BYTES);
        hipOccupancyMaxActiveBlocksPerMultiprocessor(&per_cu, (const void*)fwd_kernel, NTHR, LDS_BYTES);
        if (per_cu < 1) per_cu = 1;
        grid = cus * per_cu;
        (void)hipGetLastError();
    }
    if (grid < 0) return;
    Args a{};
    for (int i = 0; i < 16; ++i) a.in[i] = (const float*)d_in[i];
    a.out = (float*)d_out; a.ws = (unsigned char*)d_ws;
    hipError_t e = hipSuccess;
    if (N_LAUNCHES == 1) {
        a.ph_lo = 0; a.ph_hi = 11;
        void* args[] = {&a};
        e = hipLaunchCooperativeKernel((const void*)fwd_kernel, dim3(grid), dim3(NTHR), args, LDS_BYTES, stream);
    } else {
        for (int ph = 0; ph < DBG_NPH; ++ph) { a.ph_lo = ph; a.ph_hi = ph + 1; hipLaunchKernelGGL(fwd_kernel, dim3(grid), dim3(NTHR), LDS_BYTES, stream, a); }
        e = hipPeekAtLastError();
    }
    if (e != hipSuccess) fprintf(stderr, "launch failed: %s (grid %d)\n", hipGetErrorString(e), grid);
}
```
